# Optimizing an MI355X kernel written in HIP

```python
import jax, jax.numpy as jnp
from jax import lax
import numpy as np

D_MODEL = 2048
BATCH = 4
SEQ = 2048
DEPTH = 1

CHUNK = 64
N_PAST_CHUNKS = 8
BAND = (N_PAST_CHUNKS + 1) * CHUNK
ATTN_WIDTH = D_MODEL // 2
ATTN_HEAD_DIM = 64
ATTN_HEADS = ATTN_WIDTH // ATTN_HEAD_DIM
MAX_REL = 4 * CHUNK
REC_WIDTH = D_MODEL - ATTN_WIDTH
REC_HEAD_DIM = 128
REC_HEADS = REC_WIDTH // REC_HEAD_DIM
MIX_WIDTH = ATTN_WIDTH + REC_WIDTH
IN_PROJ_WIDTH = 3 * ATTN_WIDTH + 4 * REC_WIDTH
D_FF = ((8 * D_MODEL // 3 + 255) // 256) * 256
ALPHA = (2 * DEPTH) ** 0.25
BETA = (8 * DEPTH) ** -0.25
EPS = 1e-5
N_MOD = 6

kernel_name = "hybrid_chunkattn_hgrn2_deepnorm_adaln"


def _layernorm(x, g=None, b=None):
    xf = x.astype(jnp.float32)
    mu = jnp.mean(xf, axis=-1, keepdims=True)
    var = jnp.mean(jnp.square(xf - mu), axis=-1, keepdims=True)
    y = (xf - mu) * lax.rsqrt(var + EPS)
    if g is not None:
        y = y * g.astype(jnp.float32) + b.astype(jnp.float32)
    return y.astype(x.dtype)


def _rmsnorm(x, g):
    xf = x.astype(jnp.float32)
    y = xf * lax.rsqrt(jnp.mean(jnp.square(xf), axis=-1, keepdims=True) + EPS)
    return y * g.astype(jnp.float32)


def _chunk_attention(q, k, v, rel_bias):
    B, T, H, Dh = q.shape
    n_chunks = T // CHUNK
    pad = N_PAST_CHUNKS * CHUNK
    k_pad = jnp.pad(k, ((0, 0), (pad, 0), (0, 0), (0, 0)))
    v_pad = jnp.pad(v, ((0, 0), (pad, 0), (0, 0), (0, 0)))
    rel = jnp.arange(CHUNK)[:, None] + pad - jnp.arange(BAND)[None, :]
    idx = jnp.clip(rel, -MAX_REL, MAX_REL) + MAX_REL
    bias = rel_bias[:, idx].astype(jnp.float32)
    q_chunks = q.reshape(B, n_chunks, CHUNK, H, Dh).transpose(1, 0, 2, 3, 4)
    scale = Dh ** -0.5
    band_pos = jnp.arange(BAND)

    def one_chunk(args):
        n, qc = args
        kb = lax.dynamic_slice_in_dim(k_pad, n * CHUNK, BAND, axis=1)
        vb = lax.dynamic_slice_in_dim(v_pad, n * CHUNK, BAND, axis=1)
        s = jnp.einsum('bthd,bjhd->bhtj', qc, kb).astype(jnp.float32) * scale + bias
        valid = band_pos >= (N_PAST_CHUNKS - n) * CHUNK
        s = jnp.where(valid, s, -jnp.inf)
        p = jax.nn.softmax(s, axis=-1).astype(vb.dtype)
        return jnp.einsum('bhtj,bjhd->bthd', p, vb)

    out = lax.map(one_chunk, (jnp.arange(n_chunks), q_chunks))
    return out.transpose(1, 0, 2, 3, 4).reshape(B, T, H, Dh)


def _hgrn2(q, f_logit, i, lower_bound):
    B, T, H, Dk = q.shape
    lb = lower_bound.reshape(H, Dk).astype(jnp.float32)
    f = lb + (1.0 - lb) * jax.nn.sigmoid(f_logit.astype(jnp.float32))
    log_f = jnp.log(f)
    k = 1.0 - f
    q = jax.nn.silu(q.astype(jnp.float32))
    i = i.astype(jnp.float32)
    Dv = i.shape[-1]
    n_chunks = T // CHUNK

    def to_chunks(a):
        return a.reshape(B, n_chunks, CHUNK, H, a.shape[-1]).transpose(1, 0, 3, 2, 4)

    causal = jnp.tril(jnp.ones((CHUNK, CHUNK), dtype=bool))[:, :, None]

    def step(S, inp):
        qc, kc, ic, gc = inp
        b = jnp.cumsum(gc, axis=2)
        diff = b[:, :, :, None, :] - b[:, :, None, :, :]
        decay = jnp.exp(jnp.where(causal, diff, -jnp.inf))
        scores = jnp.einsum('bhtd,bhtsd,bhsd->bhts', qc, decay, kc)
        o = (jnp.einsum('bhts,bhse->bhte', scores, ic)
             + jnp.einsum('bhtd,bhde->bhte', qc * jnp.exp(b), S))
        b_last = b[:, :, -1:, :]
        S = (jnp.exp(b_last[:, :, 0, :, None]) * S
             + jnp.einsum('bhsd,bhse->bhde', kc * jnp.exp(b_last - b), ic))
        return S, o

    S0 = jnp.zeros((B, H, Dk, Dv), jnp.float32)
    _, o = lax.scan(step, S0, (to_chunks(q), to_chunks(k), to_chunks(i), to_chunks(log_f)))
    return o.transpose(1, 0, 3, 2, 4).reshape(B, T, H, Dv)


def _token_mixer(h, w_in, rel_bias, attn_gain, lower_bound, gnorm_gain, w_o):
    B, T, _ = h.shape
    proj = h @ w_in
    splits = [ATTN_WIDTH, 2 * ATTN_WIDTH, 3 * ATTN_WIDTH,
              3 * ATTN_WIDTH + REC_WIDTH, 3 * ATTN_WIDTH + 2 * REC_WIDTH,
              3 * ATTN_WIDTH + 3 * REC_WIDTH]
    q_a, k_a, v_a, q_b, f_b, i_b, g_b = jnp.split(proj, splits, axis=-1)
    heads_a = lambda a: a.reshape(B, T, ATTN_HEADS, ATTN_HEAD_DIM)
    heads_b = lambda a: a.reshape(B, T, REC_HEADS, REC_HEAD_DIM)
    o_a = _chunk_attention(heads_a(q_a), heads_a(k_a), heads_a(v_a), rel_bias)
    o_a = _rmsnorm(o_a, attn_gain.reshape(ATTN_HEADS, ATTN_HEAD_DIM)).reshape(B, T, ATTN_WIDTH)
    o_b = _hgrn2(heads_b(q_b), heads_b(f_b), heads_b(i_b), lower_bound)
    o_b = _rmsnorm(o_b, gnorm_gain).reshape(B, T, REC_WIDTH)
    o_b = o_b * jax.nn.silu(g_b.astype(jnp.float32))
    out = jnp.concatenate([o_a, o_b], axis=-1).astype(h.dtype)
    return out @ w_o


def _swiglu(h, w_ffn_in, w_ffn_out):
    gate, up = jnp.split(h @ w_ffn_in, 2, axis=-1)
    return (jax.nn.silu(gate) * up) @ w_ffn_out


def setup_inputs(seed: int = 0) -> dict:
    key = jax.random.key(seed)
    ks = jax.random.split(key, 20)
    f32 = jnp.float32
    nrm = lambda k, shape, s: jax.random.normal(k, shape, f32) * s
    return {
        "x": nrm(ks[0], (BATCH, SEQ, D_MODEL), 1.0),
        "c": nrm(ks[1], (BATCH, D_MODEL), 1.0),
        "w_ada": nrm(ks[2], (DEPTH, D_MODEL, N_MOD * D_MODEL), 0.5 * D_MODEL ** -0.5),
        "b_ada": nrm(ks[3], (DEPTH, N_MOD * D_MODEL), 0.01),
        "w_in": nrm(ks[4], (DEPTH, D_MODEL, IN_PROJ_WIDTH), D_MODEL ** -0.5),
        "rel_bias": nrm(ks[5], (DEPTH, ATTN_HEADS, 2 * MAX_REL + 1), 0.1),
        "attn_norm_g": 1.0 + nrm(ks[6], (DEPTH, ATTN_WIDTH), 0.02),
        "lb_logits": nrm(ks[7], (DEPTH + 1, REC_WIDTH), 0.1),
        "gnorm_g": 1.0 + nrm(ks[8], (DEPTH, REC_HEAD_DIM), 0.02),
        "w_o": nrm(ks[9], (DEPTH, MIX_WIDTH, D_MODEL), BETA * MIX_WIDTH ** -0.5),
        "ln1_g": 1.0 + nrm(ks[10], (DEPTH, D_MODEL), 0.02),
        "ln1_b": nrm(ks[11], (DEPTH, D_MODEL), 0.01),
        "w_ffn_in": nrm(ks[12], (DEPTH, D_MODEL, 2 * D_FF), D_MODEL ** -0.5),
        "w_ffn_out": nrm(ks[13], (DEPTH, D_FF, D_MODEL), BETA * D_FF ** -0.5),
        "ln2_g": 1.0 + nrm(ks[14], (DEPTH, D_MODEL), 0.02),
        "ln2_b": nrm(ks[15], (DEPTH, D_MODEL), 0.01),
    }


def reference(x, c, w_ada, b_ada, w_in, rel_bias, attn_norm_g, lb_logits, gnorm_g, w_o,
              ln1_g, ln1_b, w_ffn_in, w_ffn_out, ln2_g, ln2_b):
    lower_bounds = jnp.cumsum(jax.nn.softmax(lb_logits.astype(jnp.float32), axis=0), axis=0)
    c_act = jax.nn.silu(c)
    for layer in range(DEPTH):
        mod = c_act @ w_ada[layer] + b_ada[layer]
        shift1, scale1, gate1, shift2, scale2, gate2 = [m[:, None, :] for m in jnp.split(mod, N_MOD, axis=-1)]
        h = _layernorm(x) * (1.0 + scale1) + shift1
        mix = _token_mixer(h, w_in[layer], rel_bias[layer], attn_norm_g[layer],
                           lower_bounds[layer], gnorm_g[layer], w_o[layer])
        x = _layernorm(ALPHA * x + gate1 * mix, ln1_g[layer], ln1_b[layer])
        h = _layernorm(x) * (1.0 + scale2) + shift2
        x = _layernorm(ALPHA * x + gate2 * _swiglu(h, w_ffn_in[layer], w_ffn_out[layer]),
                       ln2_g[layer], ln2_b[layer])
    return x
```

```cpp
#include <hip/hip_runtime.h>
#include <hip/hip_cooperative_groups.h>
#include <cstdio>
#include <cstdint>
namespace cg = cooperative_groups;
namespace pg8 {
#define PG8_LAS __attribute__((address_space(3)))
typedef unsigned short bf16_t;
typedef short bf16x8 __attribute__((ext_vector_type(8)));
typedef float f32x4 __attribute__((ext_vector_type(4)));
typedef unsigned u32x4 __attribute__((ext_vector_type(4)));
constexpr int BM = 256, BK = 64, HALF = 128, HTB = HALF * BK * 2  , STAGE_BYTES = 8 * HTB, NXCD = 8, WGM = 8;

__host__ __device__ __forceinline__ int lds_byte(int r, int c) { const int st = (r >> 4) * 2 + (c >> 5), rr = r & 15, cc = c & 31, ob = rr * 64 + cc * 2; return st * 1024 + (ob ^ (((ob >> 9) & 1) << 5)); }
__host__ __device__ __forceinline__ void stage_rc(int b, int& R, int& C) { const int st = b / 1024, sb = b % 1024, swz = sb ^ (((sb >> 9) & 1) << 5); R = (st >> 1) * 16 + swz / 64; C = (st & 1) * 32 + (swz % 64) / 2; }
__host__ __device__ __forceinline__ int perm32(int rho) { const int n = rho >> 4, i = rho & 15; return 8 * (i >> 2) + 4 * n + (i & 3); }

struct Unit { int pm, pn; };
struct Gemm { const bf16_t* A; const bf16_t* Bt; int M, N, K; };

struct StaticOrder {
    int nM, nN, nwg, G, c;
    __host__ __device__ void init(int M, int N, int G_, int c_) { nM = M / BM; nN = N / BM; nwg = nM * nN; G = G_; c = c_; }
    __host__ __device__ bool next(int i, Unit& u) const {
        const long L = (long)i * G + c; if (L >= nwg) return false;
        int wgid = (int)L; { const int q = nwg / NXCD, r = nwg % NXCD, xcd = wgid % NXCD, off = wgid / NXCD; wgid = (xcd < r ? xcd * (q + 1) : r * (q + 1) + (xcd - r) * q) + off; }
        const int nig = WGM * nN, gid = wgid / nig, fm = gid * WGM, gsz = (nM - fm) < WGM ? (nM - fm) : WGM;
        u.pm = fm + ((wgid % nig) % gsz); u.pn = (wgid % nig) / gsz; return true;
    }
    __device__ __forceinline__ void a_ready(const Unit&) const {}
    __device__ __forceinline__ void done(const Unit&) const {}
};

template <class Epi, class Sched, bool ALIGN_EPI = false, bool SP2 = false>
__device__ __forceinline__ void gemm_phase(PG8_LAS unsigned char* lds, const Gemm g, const Sched& S, const Epi& E) {
    const int tid = threadIdx.x, wid = __builtin_amdgcn_readfirstlane(tid >> 6), lane = tid & 63, wr = wid >> 2, wc = wid & 3, fr = lane & 15, fq = lane >> 4;
    const int K = g.K, nt = K / BK;
    unsigned voffA[2], voffB[2];
#pragma unroll
    for (int i = 0; i < 2; ++i) { int R, C; stage_rc(tid * 16 + i * 8192, R, C); const int Rb = Epi::PERM ? ((R & ~31) + perm32(R & 31)) : R;
        voffA[i] = (unsigned)(R * K + C) * 2u; voffB[i] = (unsigned)(Rb * K + C) * 2u; }
    const size_t kstep = (size_t)(BK * 2);
    const size_t hstep = (size_t)HALF * K * 2;
    const size_t tstep = 2 * hstep;
    const unsigned ldsw = (unsigned)wid * 1024u;
    const int aoff = lds_byte(wr * 64 + fr, fq * 8), boff = lds_byte(wc * 32 + fr, fq * 8);
#define PG8_SA(b, h) (((b) * 2 + (h)) * HTB)
#define PG8_SB(b, h) ((4 + (b) * 2 + (h)) * HTB)
#define PG8_STAGE(bufoff, gbase, voff) do { _Pragma("unroll") for (int _i = 0; _i < 2; ++_i) \
        __builtin_amdgcn_global_load_lds((const unsigned*)((const char*)(gbase) + (voff)[_i]), (PG8_LAS unsigned*)(lds + (bufoff) + ldsw + _i * 8192), 16, 0, 0); } while (0)
#define PG8_LDA(dst, b, h) do { _Pragma("unroll") for (int m = 0; m < 4; ++m) _Pragma("unroll") for (int k = 0; k < 2; ++k) dst[m][k] = *(const PG8_LAS bf16x8*)(lds + PG8_SA(b, h) + aoff + m * 2048 + k * 1024); } while (0)
#define PG8_LDB(dst, b, h) do { _Pragma("unroll") for (int n = 0; n < 2; ++n) _Pragma("unroll") for (int k = 0; k < 2; ++k) dst[n][k] = *(const PG8_LAS bf16x8*)(lds + PG8_SB(b, h) + boff + n * 2048 + k * 1024); } while (0)
#define PG8_MMA(ai, bj, At, Bt) do { __builtin_amdgcn_s_setprio(1); _Pragma("unroll") for (int m = 0; m < 4; ++m) _Pragma("unroll") for (int n = 0; n < 2; ++n) _Pragma("unroll") for (int k = 0; k < 2; ++k) \
        acc[ai][bj][m][n] = __builtin_amdgcn_mfma_f32_16x16x32_bf16(Bt[n][k], At[m][k], acc[ai][bj][m][n], 0, 0, 0); __builtin_amdgcn_s_setprio(0); } while (0)
#define PG8_WAIT_V(n) asm volatile("s_waitcnt vmcnt(" #n ")" ::: "memory")
#define PG8_WAIT_L(n) asm volatile("s_waitcnt lgkmcnt(" #n ")" ::: "memory")
#define PG8_BAR __builtin_amdgcn_s_barrier()
#define PG8_SCHED __builtin_amdgcn_sched_barrier(0)
    Unit cur, nxt; int ui = 0;
    if (!S.next(0, cur)) return;
    f32x4 acc[2][2][4][2];
#pragma unroll
    for (int a = 0; a < 2; ++a)
#pragma unroll
        for (int b = 0; b < 2; ++b)
#pragma unroll
            for (int m = 0; m < 4; ++m)
#pragma unroll
                for (int n = 0; n < 2; ++n) acc[a][b][m][n] = (f32x4){0.f, 0.f, 0.f, 0.f};
    bf16x8 At[4][2], B0[2][2], B1[2][2];
    const char* cA = (const char*)g.A + (size_t)cur.pm * tstep; const char* cB = (const char*)g.Bt + (size_t)cur.pn * tstep;
    S.a_ready(cur);
    if constexpr (SP2) {
        PG8_STAGE(PG8_SB(0, 0), cB, voffB); PG8_STAGE(PG8_SB(0, 1), cB + hstep, voffB); PG8_STAGE(PG8_SA(0, 0), cA, voffA); PG8_STAGE(PG8_SA(0, 1), cA + hstep, voffA);
        if (wr == 1) PG8_BAR;
        PG8_WAIT_V(2); PG8_BAR;
        PG8_STAGE(PG8_SB(1, 0), cB + kstep, voffB); PG8_STAGE(PG8_SA(1, 0), cA + kstep, voffA); PG8_STAGE(PG8_SB(1, 1), cB + hstep + kstep, voffB);
        PG8_WAIT_V(6); PG8_BAR;
    } else {
        PG8_STAGE(PG8_SB(0, 0), cB, voffB); PG8_STAGE(PG8_SA(0, 0), cA, voffA); PG8_STAGE(PG8_SB(0, 1), cB + hstep, voffB); PG8_STAGE(PG8_SA(0, 1), cA + hstep, voffA);
        if (wr == 1) PG8_BAR;
        PG8_WAIT_V(4); PG8_BAR;
        PG8_STAGE(PG8_SB(1, 0), cB + kstep, voffB); PG8_STAGE(PG8_SA(1, 0), cA + kstep, voffA); PG8_STAGE(PG8_SB(1, 1), cB + hstep + kstep, voffB);
        PG8_WAIT_V(6); PG8_BAR;
    }
    for (;;) {
        const bool has_next = S.next(ui + 1, nxt);
        const char* nA = has_next ? (const char*)g.A + (size_t)nxt.pm * tstep : cA; const char* nB = has_next ? (const char*)g.Bt + (size_t)nxt.pn * tstep : cB;
        for (int t = 0; t < nt; t += 2) {
            const bool last = (t == nt - 2);
            const char* a1 = cA + (size_t)(t + 1) * kstep;
            const char* a2 = last ? nA : cA + (size_t)(t + 2) * kstep; const char* b2 = last ? nB : cB + (size_t)(t + 2) * kstep;
            const char* a3 = a2 + kstep; const char* b3 = b2 + kstep;
            if (last && has_next) S.a_ready(nxt);
            if constexpr (SP2) {
            PG8_LDB(B0, 0, 0); PG8_LDB(B1, 0, 1); PG8_SCHED; PG8_LDA(At, 0, 0); PG8_STAGE(PG8_SA(1, 1), a1 + hstep, voffA);
            PG8_WAIT_V(8); PG8_WAIT_L(0); PG8_BAR; PG8_MMA(0, 0, At, B0); PG8_MMA(0, 1, At, B1); PG8_BAR; PG8_SCHED;
            PG8_LDA(At, 0, 1); PG8_STAGE(PG8_SB(0, 0), b2, voffB); PG8_STAGE(PG8_SB(0, 1), b2 + hstep, voffB); PG8_STAGE(PG8_SA(0, 0), a2, voffA);
            PG8_WAIT_V(8); PG8_WAIT_L(0); PG8_BAR; PG8_MMA(1, 0, At, B0); PG8_MMA(1, 1, At, B1); PG8_BAR; PG8_SCHED;
            PG8_LDB(B0, 1, 0); PG8_LDB(B1, 1, 1); PG8_SCHED; PG8_LDA(At, 1, 0); PG8_STAGE(PG8_SA(0, 1), a2 + hstep, voffA);
            PG8_WAIT_V(8); PG8_WAIT_L(0); PG8_BAR; PG8_MMA(0, 0, At, B0); PG8_MMA(0, 1, At, B1); PG8_BAR; PG8_SCHED;
            PG8_LDA(At, 1, 1); PG8_STAGE(PG8_SB(1, 0), b3, voffB); PG8_STAGE(PG8_SB(1, 1), b3 + hstep, voffB); PG8_STAGE(PG8_SA(1, 0), a3, voffA);
            PG8_WAIT_V(8); PG8_WAIT_L(0); PG8_BAR; PG8_MMA(1, 0, At, B0); PG8_MMA(1, 1, At, B1); PG8_BAR; PG8_SCHED;
            } else {
            PG8_LDB(B0, 0, 0); PG8_SCHED; PG8_LDA(At, 0, 0); PG8_STAGE(PG8_SA(1, 1), a1 + hstep, voffA);
            PG8_WAIT_L(8); PG8_BAR; PG8_WAIT_L(0); PG8_MMA(0, 0, At, B0); PG8_BAR; PG8_SCHED;
            PG8_LDB(B1, 0, 1); PG8_STAGE(PG8_SB(0, 0), b2, voffB);
            PG8_BAR; PG8_WAIT_L(0); PG8_MMA(0, 1, At, B1); PG8_BAR;
            PG8_LDA(At, 0, 1); PG8_STAGE(PG8_SA(0, 0), a2, voffA);
            PG8_BAR; PG8_WAIT_L(0); PG8_MMA(1, 0, At, B0); PG8_BAR; PG8_SCHED;
            PG8_STAGE(PG8_SB(0, 1), b2 + hstep, voffB);
            PG8_WAIT_V(6); PG8_BAR; PG8_MMA(1, 1, At, B1); PG8_BAR;
            PG8_LDB(B0, 1, 0); PG8_SCHED; PG8_LDA(At, 1, 0); PG8_STAGE(PG8_SA(0, 1), a2 + hstep, voffA);
            PG8_WAIT_L(8); PG8_BAR; PG8_WAIT_L(0); PG8_MMA(0, 0, At, B0); PG8_BAR; PG8_SCHED;
            PG8_LDB(B1, 1, 1); PG8_STAGE(PG8_SB(1, 0), b3, voffB);
            PG8_BAR; PG8_WAIT_L(0); PG8_MMA(0, 1, At, B1); PG8_BAR;
            PG8_LDA(At, 1, 1); PG8_STAGE(PG8_SA(1, 0), a3, voffA);
            PG8_BAR; PG8_WAIT_L(0); PG8_MMA(1, 0, At, B0); PG8_BAR; PG8_SCHED;
            PG8_STAGE(PG8_SB(1, 1), b3 + hstep, voffB);
            PG8_WAIT_V(6); PG8_BAR; PG8_MMA(1, 1, At, B1); PG8_BAR;
            }
        }
        if constexpr (ALIGN_EPI) { if (wr == 0) PG8_BAR; }
        if constexpr (!Epi::AFTER_DRAIN) { E(acc, cur, wr, wc, fr, fq); S.done(cur); }
        if (!has_next) break;
#pragma unroll
        for (int a = 0; a < 2; ++a)
#pragma unroll
            for (int b = 0; b < 2; ++b)
#pragma unroll
                for (int m = 0; m < 4; ++m)
#pragma unroll
                    for (int n = 0; n < 2; ++n) acc[a][b][m][n] = (f32x4){0.f, 0.f, 0.f, 0.f};
        cur = nxt; cA = nA; cB = nB; ++ui;
        if constexpr (ALIGN_EPI) { if (wr == 1) PG8_BAR; }
    }
    PG8_WAIT_V(0);
    if constexpr (!ALIGN_EPI) { if (wr == 0) PG8_BAR; }
    PG8_BAR;
    if constexpr (Epi::AFTER_DRAIN) { E.fused(acc, cur, wr, wc, fr, fq, lds, wid, lane); S.done(cur); }
#undef PG8_SA
#undef PG8_SB
#undef PG8_STAGE
#undef PG8_LDA
#undef PG8_LDB
#undef PG8_MMA
#undef PG8_WAIT_V
#undef PG8_WAIT_L
#undef PG8_BAR
#undef PG8_SCHED
}
}

constexpr int NB = 4, SEQ = 2048, DM = 2048, MROWS = NB * SEQ;
constexpr int NIN = 7168, DFF = 5632, NFF2 = 2 * DFF, NMOD = 6 * DM;
constexpr int AWID = 1024;
constexpr float LN_EPS = 1e-5f;
constexpr float ALPHA = 1.189207115002721f;
constexpr float LOG2E = 1.4426950408889634f;
constexpr float QSCALE = 0.125f * LOG2E;

constexpr size_t MiB = 1u << 20;
constexpr size_t WS_MODP = 2 * MiB;
constexpr size_t WS_MODF = 2 * MiB + 1572864;
constexpr size_t WS_WIN = 4 * MiB, WS_WO = 32 * MiB, WS_WFI = 40 * MiB, WS_WFO = 84 * MiB;
constexpr size_t WS_ADEC = 106 * MiB;
constexpr size_t WS_H = 108 * MiB;
constexpr size_t WS_QA = 140 * MiB, WS_KA = 156 * MiB, WS_VA = 172 * MiB, WS_QB = 188 * MiB, WS_IB = 204 * MiB, WS_GB = 220 * MiB;
constexpr size_t WS_GL = 236 * MiB;
constexpr size_t WS_MIX = 268 * MiB;
constexpr size_t WS_U = 300 * MiB, WS_SP = 332 * MiB;
constexpr size_t WS_Y1 = 140 * MiB, WS_X1 = 204 * MiB;
constexpr size_t WS_UFF = 268 * MiB;
constexpr size_t WS_END = 364 * MiB;

constexpr int LDS_BYTES = 147456;
constexpr int NTHR = 512;

#define LAS __attribute__((address_space(3)))
typedef unsigned short bf16_t;
typedef short bf16x8 __attribute__((ext_vector_type(8)));
typedef short s16x4 __attribute__((ext_vector_type(4)));
typedef float f32x4 __attribute__((ext_vector_type(4)));
typedef float f32x2 __attribute__((ext_vector_type(2)));
typedef float f32x16 __attribute__((ext_vector_type(16)));
typedef unsigned u32x4 __attribute__((ext_vector_type(4)));
typedef unsigned u32x2 __attribute__((ext_vector_type(2)));
typedef __bf16 bf16x2_t __attribute__((ext_vector_type(2)));

__device__ __forceinline__ unsigned pk2(float lo, float hi) { f32x2 v = {lo, hi}; bf16x2_t b = __builtin_convertvector(v, bf16x2_t); return __builtin_bit_cast(unsigned, b); }
__device__ __forceinline__ bf16_t f2bf(float x) { return (bf16_t)(pk2(x, 0.f) & 0xffffu); }
__device__ __forceinline__ float bf2f(unsigned v) { return __uint_as_float(v << 16); }
__device__ __forceinline__ float bflo(unsigned w) { return __uint_as_float(w << 16); }
__device__ __forceinline__ float bfhi(unsigned w) { return __uint_as_float(w & 0xffff0000u); }
__device__ __forceinline__ float fast_exp(float x) { return __builtin_amdgcn_exp2f(x * LOG2E); }
__device__ __forceinline__ float silu_f(float x) { return x * __builtin_amdgcn_rcpf(1.f + __builtin_amdgcn_exp2f(-x * LOG2E)); }
__device__ __forceinline__ float wave_sum(float v) {
#pragma unroll
    for (int o = 1; o < 64; o <<= 1) v += __shfl_xor(v, o);
    return v;
}

struct EpiInProj {
    static constexpr bool PERM = true, AFTER_DRAIN = false;
    bf16_t *qa, *ka, *va, *qb, *ib, *gb; float* gl; const float* lbl;
    __device__ __forceinline__ void operator()(const f32x4 (&acc)[2][2][4][2], const pg8::Unit& u, int wr, int wc, int fr, int fq) const {
        const int seg = u.pn >> 2; const int colt = (u.pn & 3) * 256 + wc * 32 + 8 * fq; const int row0 = u.pm * 256 + wr * 64 + fr;
        if (seg == 4) {
#pragma unroll
            for (int bj = 0; bj < 2; ++bj) {
                const int c = colt + bj * 128; float lb[8];
#pragma unroll
                for (int i = 0; i < 8; ++i) { const float l0 = lbl[c + i], l1 = lbl[1024 + c + i]; lb[i] = 1.f / (1.f + __expf(l1 - l0)); }
#pragma unroll
                for (int ai = 0; ai < 2; ++ai)
#pragma unroll
                    for (int m = 0; m < 4; ++m) {
                        float* rp = gl + (size_t)(row0 + ai * 128 + m * 16) * AWID + c; f32x4 o0, o1;
#pragma unroll
                        for (int i = 0; i < 4; ++i) {
                            const float s0 = 1.f / (1.f + __expf(-acc[ai][bj][m][0][i])), s1 = 1.f / (1.f + __expf(-acc[ai][bj][m][1][i]));
                            o0[i] = __logf(lb[i] + (1.f - lb[i]) * s0); o1[i] = __logf(lb[4 + i] + (1.f - lb[4 + i]) * s1);
                        }
                        *(f32x4*)rp = o0; *(f32x4*)(rp + 4) = o1;
                    }
            }
        } else {
            bf16_t* base = seg == 0 ? qa : seg == 1 ? ka : seg == 2 ? va : seg == 3 ? qb : seg == 5 ? ib : gb;
            const bool act = (seg == 3 || seg == 6); const float sc = seg == 0 ? QSCALE : 1.f;
#pragma unroll
            for (int ai = 0; ai < 2; ++ai)
#pragma unroll
                for (int m = 0; m < 4; ++m) {
                    bf16_t* rp = base + (size_t)(row0 + ai * 128 + m * 16) * AWID + colt;
#pragma unroll
                    for (int bj = 0; bj < 2; ++bj) {
                        f32x4 v0 = acc[ai][bj][m][0], v1 = acc[ai][bj][m][1];
                        if (act) {
#pragma unroll
                            for (int i = 0; i < 4; ++i) { v0[i] = silu_f(v0[i]); v1[i] = silu_f(v1[i]); }
                        }
                        v0 = v0 * sc; v1 = v1 * sc;
                        u32x4 w; w.x = pk2(v0[0], v0[1]); w.y = pk2(v0[2], v0[3]); w.z = pk2(v1[0], v1[1]); w.w = pk2(v1[2], v1[3]);
                        *(u32x4*)(rp + bj * 128) = w;
                    }
                }
        }
    }
};
struct EpiResid {
    static constexpr bool PERM = true, AFTER_DRAIN = false;
    const float* base; const float* gate; float* out;
    __device__ __forceinline__ void operator()(const f32x4 (&acc)[2][2][4][2], const pg8::Unit& u, int wr, int wc, int fr, int fq) const {
        const int row0 = u.pm * 256 + wr * 64 + fr, batch = u.pm >> 3, col0 = u.pn * 256 + wc * 32 + 8 * fq;
#pragma unroll
        for (int bj = 0; bj < 2; ++bj) {
            const int c = col0 + bj * 128;
            const f32x4 g0 = *(const f32x4*)(gate + (size_t)batch * NMOD + c), g1 = *(const f32x4*)(gate + (size_t)batch * NMOD + c + 4);
#pragma unroll
            for (int ai = 0; ai < 2; ++ai)
#pragma unroll
                for (int m = 0; m < 4; ++m) {
                    const size_t off = (size_t)(row0 + ai * 128 + m * 16) * DM + c;
                    const f32x4 b0 = *(const f32x4*)(base + off), b1 = *(const f32x4*)(base + off + 4);
                    *(f32x4*)(out + off) = b0 * ALPHA + g0 * acc[ai][bj][m][0];
                    *(f32x4*)(out + off + 4) = b1 * ALPHA + g1 * acc[ai][bj][m][1];
                }
        }
    }
};
struct EpiSwiglu {
    static constexpr bool PERM = true, AFTER_DRAIN = false;
    bf16_t* U;
    __device__ __forceinline__ void operator()(const f32x4 (&acc)[2][2][4][2], const pg8::Unit& u, int wr, int wc, int fr, int fq) const {
        const int row0 = u.pm * 256 + wr * 64 + fr, col0 = u.pn * 128 + wc * 32 + 8 * fq;
#pragma unroll
        for (int ai = 0; ai < 2; ++ai)
#pragma unroll
            for (int m = 0; m < 4; ++m) {
                f32x4 r0, r1;
#pragma unroll
                for (int i = 0; i < 4; ++i) { r0[i] = silu_f(acc[ai][0][m][0][i]) * acc[ai][1][m][0][i]; r1[i] = silu_f(acc[ai][0][m][1][i]) * acc[ai][1][m][1][i]; }
                u32x4 w; w.x = pk2(r0[0], r0[1]); w.y = pk2(r0[2], r0[3]); w.z = pk2(r1[0], r1[1]); w.w = pk2(r1[2], r1[3]);
                *(u32x4*)(U + (size_t)(row0 + ai * 128 + m * 16) * DFF + col0) = w;
            }
    }
};

struct Args { const float* in[16]; float* out; unsigned char* ws; int ph_lo, ph_hi; };
struct Ctx { LAS unsigned char* lds; int tid, lane, wave; };

template <int K> __device__ __forceinline__ f32x4 mma16(const LAS bf16_t* A, int sa, const LAS bf16_t* Bt, int sb, int fr, int fq, f32x4 acc) {
#pragma unroll
    for (int k0 = 0; k0 < K; k0 += 32) {
        const bf16x8 a = *(const LAS bf16x8*)(A + fr * sa + k0 + 8 * fq), b = *(const LAS bf16x8*)(Bt + fr * sb + k0 + 8 * fq);
        acc = __builtin_amdgcn_mfma_f32_16x16x32_bf16(a, b, acc, 0, 0, 0);
    }
    return acc;
}

__device__ __forceinline__ void ph_mod_partial(const Ctx& X, const float* c, const float* w_ada, float* modp) {
    LAS float* red = (LAS float*)X.lds;
    for (int item = blockIdx.x; item < 768; item += gridDim.x) {
        const int ks = item / 96, cb = item % 96, k0 = ks * 256 + X.wave * 32;
        float cv[4];
#pragma unroll
        for (int b = 0; b < 4; ++b) { const float v = c[b * DM + k0 + (X.lane & 31)]; cv[b] = v / (1.f + __expf(-v)); }
        f32x2 acc[4];
#pragma unroll
        for (int b = 0; b < 4; ++b) acc[b] = (f32x2){0.f, 0.f};
        const float* wp = w_ada + (size_t)k0 * NMOD + cb * 128 + X.lane * 2;
#pragma unroll
        for (int i = 0; i < 32; ++i) {
            const f32x2 w = *(const f32x2*)(wp + (size_t)i * NMOD);
#pragma unroll
            for (int b = 0; b < 4; ++b) { const float s = __shfl(cv[b], i); acc[b] += w * s; }
        }
#pragma unroll
        for (int b = 0; b < 4; ++b) *(LAS f32x2*)(red + (X.wave * 4 + b) * 128 + X.lane * 2) = acc[b];
        __syncthreads();
        { const int b = X.tid >> 7, cc = X.tid & 127; float s = 0.f;
#pragma unroll
          for (int w = 0; w < 8; ++w) s += red[(w * 4 + b) * 128 + cc];
          modp[(size_t)(ks * 4 + b) * NMOD + cb * 128 + cc] = s; }
        __syncthreads();
    }
}

__device__ __forceinline__ float mod_value(const float* modp, const float* b_ada, int batch, int mc) {
    float s = b_ada[mc];
#pragma unroll
    for (int ks = 0; ks < 8; ++ks) s += modp[(size_t)(ks * 4 + batch) * NMOD + mc];
    return s;
}
__device__ __forceinline__ void ln_norm8(f32x4 (&v)[8]) {
    float s = 0.f;
#pragma unroll
    for (int j = 0; j < 8; ++j) s += (v[j][0] + v[j][1]) + (v[j][2] + v[j][3]);
    const float mean = wave_sum(s) * (1.f / DM); float q = 0.f;
#pragma unroll
    for (int j = 0; j < 8; ++j) { v[j] = v[j] - mean; q += (v[j][0] * v[j][0] + v[j][1] * v[j][1]) + (v[j][2] * v[j][2] + v[j][3] * v[j][3]); }
    const float rstd = 1.f / sqrtf(wave_sum(q) * (1.f / DM) + LN_EPS);
#pragma unroll
    for (int j = 0; j < 8; ++j) v[j] = v[j] * rstd;
}
__device__ __forceinline__ void ph_h1(const Ctx& X, const float* x, const float* modp, const float* b_ada, bf16_t* h) {
    LAS float* tab = (LAS float*)X.lds;
    for (int rb = blockIdx.x; rb < 256; rb += gridDim.x) {
        const int batch = rb >> 6;
        for (int i = X.tid; i < 4096; i += NTHR) { const float s = mod_value(modp, b_ada, batch, i); tab[i] = (i >= 2048) ? 1.f + s : s; }
        __syncthreads();
        for (int r = X.wave; r < 32; r += 8) {
            const size_t row = (size_t)rb * 32 + r; const float* xr = x + row * DM + 4 * X.lane;
            f32x4 v[8];
#pragma unroll
            for (int j = 0; j < 8; ++j) v[j] = *(const f32x4*)(xr + 256 * j);
            ln_norm8(v);
            bf16_t* hr = h + row * DM + 4 * X.lane;
#pragma unroll
            for (int j = 0; j < 8; ++j) {
                const int c = 4 * X.lane + 256 * j; const f32x4 sh = *(const LAS f32x4*)(tab + c), sc = *(const LAS f32x4*)(tab + 2048 + c);
                const f32x4 o = v[j] * sc + sh; u32x2 w; w.x = pk2(o[0], o[1]); w.y = pk2(o[2], o[3]); *(u32x2*)(hr + 256 * j) = w;
            }
        }
        __syncthreads();
    }
}
__device__ __forceinline__ int ffi_row(int c) { const int cc = c < DFF ? c : c - DFF; return ((cc >> 7) << 8) + (c < DFF ? 0 : 128) + (cc & 127); }
__device__ __forceinline__ void transpose_item(const float* W, int K, int N, bf16_t* WT, bool ffi, LAS float* scr, int item, int lane) {
    const int nblk = N / 32, kb = item / nblk, nb = item % nblk, k0 = 64 * kb, n0 = 32 * nb;
    const int r0 = ffi ? ffi_row(n0) : n0;
#pragma unroll 8
    for (int i = 0; i < 32; ++i) { const int kk = 2 * i + (lane >> 5); scr[kk * 33 + (lane & 31)] = W[(size_t)(k0 + kk) * N + n0 + (lane & 31)]; }
    asm volatile("s_waitcnt lgkmcnt(0)" ::: "memory");
    const int c = lane & 7;
#pragma unroll
    for (int j = 0; j < 4; ++j) { const int n = (lane >> 3) + 8 * j; const LAS float* s = scr + (8 * c) * 33 + n;
        u32x4 o; o.x = pk2(s[0 * 33], s[1 * 33]); o.y = pk2(s[2 * 33], s[3 * 33]); o.z = pk2(s[4 * 33], s[5 * 33]); o.w = pk2(s[6 * 33], s[7 * 33]);
        *(u32x4*)(WT + (size_t)(r0 + n) * K + k0 + 8 * c) = o; }
    asm volatile("s_waitcnt lgkmcnt(0)" ::: "memory");
}
__device__ __forceinline__ void ph_weights(const Ctx& X, const float* w_in, const float* w_o, const float* w_fi, const float* w_fo, bf16_t* win_t, bf16_t* wo_t, bf16_t* wfi_t, bf16_t* wfo_t) {
    LAS float* scr = (LAS float*)(X.lds + X.wave * 16384);
    const int gw = blockIdx.x * 8 + X.wave, NGW = gridDim.x * 8;
    constexpr int I_IN = (DM / 64) * (NIN / 32), I_O = (DM / 64) * (DM / 32), I_FI = (DM / 64) * (NFF2 / 32), I_FO = (DFF / 64) * (DM / 32);
    for (int it = gw; it < I_IN + I_O + I_FI + I_FO; it += NGW) {
        int r = it;
        if (r < I_IN) { transpose_item(w_in, DM, NIN, win_t, false, scr, r, X.lane); continue; } r -= I_IN;
        if (r < I_O) { transpose_item(w_o, DM, DM, wo_t, false, scr, r, X.lane); continue; } r -= I_O;
        if (r < I_FI) { transpose_item(w_fi, DM, NFF2, wfi_t, true, scr, r, X.lane); continue; } r -= I_FI;
        transpose_item(w_fo, DFF, DM, wfo_t, false, scr, r, X.lane);
    }
}
__device__ __forceinline__ void ph_modf(const Ctx& X, const float* modp, const float* b_ada, float* modf) {
    for (int idx = blockIdx.x * NTHR + X.tid; idx < NB * NMOD; idx += gridDim.x * NTHR) { const int b = idx / NMOD, col = idx % NMOD; modf[idx] = mod_value(modp, b_ada, b, col); }
}

__device__ __forceinline__ void attn_unit(const Ctx& X, int b, int h, int c4, const bf16_t* qa, const bf16_t* ka, const bf16_t* va, const float* rel_bias, const float* again, bf16_t* mix) {
    constexpr int KS_OFF = 0, VT_OFF = 18432, TB_OFF = 36864, TILEB = 9216;
    const int lane = X.lane, wave = X.wave, tid = X.tid, r32 = lane & 31, hi = lane >> 5, wq = wave >> 1;
    const int qpos = (4 * c4 + wq) * 64 + (wave & 1) * 32 + r32;
    const size_t qrow = (size_t)b * SEQ + qpos;
    LAS float* tbr = (LAS float*)(X.lds + TB_OFF);
    for (int i = tid; i < 639; i += NTHR) { const int rel = 575 - i; tbr[i] = rel_bias[h * 513 + (rel < 256 ? rel : 256) + 256] * LOG2E; }
    bf16x8 qr[4];
#pragma unroll
    for (int d0 = 0; d0 < 4; ++d0) qr[d0] = *(const bf16x8*)(qa + qrow * AWID + h * 64 + d0 * 16 + hi * 8);
    f32x16 o0, o1;
#pragma unroll
    for (int r = 0; r < 16; ++r) { o0[r] = 0.f; o1[r] = 0.f; }
    float mrun = -1e30f, lrun = 0.f;
    const int tau_lo = (8 - 4 * c4) > 0 ? (8 - 4 * c4) : 0;
    const int krow = tid >> 3, kch = tid & 7, vrow = lane, vch = wave;
    const bf16_t* kbase = ka + ((size_t)b * SEQ + krow) * AWID + h * 64 + kch * 8;
    const bf16_t* vbase = va + ((size_t)b * SEQ + vrow) * AWID + h * 64 + vch * 8;
    u32x4 kreg, vreg;
#define ATT_GLOAD(tau) do { const long kt0_ = (long)(4 * c4 - 8 + (tau)) * 64; kreg = *(const u32x4*)(kbase + kt0_ * AWID); vreg = *(const u32x4*)(vbase + kt0_ * AWID); } while (0)
#define ATT_LSTORE(bufi) do { *(LAS u32x4*)(X.lds + KS_OFF + (bufi) * TILEB + krow * 144 + kch * 16) = kreg; \
        LAS bf16_t* vt_ = (LAS bf16_t*)(X.lds + VT_OFF + (bufi) * TILEB) + (vch * 8) * 72 + vrow; \
        vt_[0 * 72] = (bf16_t)(vreg.x & 0xffffu); vt_[1 * 72] = (bf16_t)(vreg.x >> 16); vt_[2 * 72] = (bf16_t)(vreg.y & 0xffffu); vt_[3 * 72] = (bf16_t)(vreg.y >> 16); \
        vt_[4 * 72] = (bf16_t)(vreg.z & 0xffffu); vt_[5 * 72] = (bf16_t)(vreg.z >> 16); vt_[6 * 72] = (bf16_t)(vreg.w & 0xffffu); vt_[7 * 72] = (bf16_t)(vreg.w >> 16); } while (0)
    ATT_GLOAD(tau_lo); ATT_LSTORE(0);
    __syncthreads();
    int buf = 0;
    for (int tau = tau_lo; tau < 12; ++tau) {
        if (tau + 1 < 12) ATT_GLOAD(tau + 1);
        if (tau >= wq && tau <= wq + 8) {
            f32x16 p0, p1;
#pragma unroll
            for (int r = 0; r < 16; ++r) { p0[r] = 0.f; p1[r] = 0.f; }
            const LAS unsigned char* kb = X.lds + KS_OFF + buf * TILEB + r32 * 144 + hi * 16;
#pragma unroll
            for (int d0 = 0; d0 < 4; ++d0) {
                const bf16x8 k0 = *(const LAS bf16x8*)(kb + d0 * 32), k1 = *(const LAS bf16x8*)(kb + 32 * 144 + d0 * 32);
                p0 = __builtin_amdgcn_mfma_f32_32x32x16_bf16(k0, qr[d0], p0, 0, 0, 0);
                p1 = __builtin_amdgcn_mfma_f32_32x32x16_bf16(k1, qr[d0], p1, 0, 0, 0);
            }
            const int kt0 = (4 * c4 - 8 + tau) * 64;
            const LAS float* tb = tbr + (575 - qpos + kt0 + 4 * hi);
            float mx = -1e30f;
#pragma unroll
            for (int r = 0; r < 16; ++r) { const int off = (r & 3) + 8 * (r >> 2); p0[r] += tb[off]; p1[r] += tb[off + 32]; mx = fmaxf(mx, fmaxf(p0[r], p1[r])); }
            mx = fmaxf(mx, __shfl_xor(mx, 32));
            const float mn = fmaxf(mrun, mx), al = __builtin_amdgcn_exp2f(mrun - mn); mrun = mn;
            float ls = 0.f;
#pragma unroll
            for (int r = 0; r < 16; ++r) { p0[r] = __builtin_amdgcn_exp2f(p0[r] - mn); p1[r] = __builtin_amdgcn_exp2f(p1[r] - mn); ls += p0[r] + p1[r]; }
            lrun = lrun * al + ls;
#pragma unroll
            for (int r = 0; r < 16; ++r) { o0[r] *= al; o1[r] *= al; }
            u32x4 pw[4];
            pw[0] = (u32x4){pk2(p0[0], p0[1]), pk2(p0[2], p0[3]), pk2(p0[4], p0[5]), pk2(p0[6], p0[7])};
            pw[1] = (u32x4){pk2(p0[8], p0[9]), pk2(p0[10], p0[11]), pk2(p0[12], p0[13]), pk2(p0[14], p0[15])};
            pw[2] = (u32x4){pk2(p1[0], p1[1]), pk2(p1[2], p1[3]), pk2(p1[4], p1[5]), pk2(p1[6], p1[7])};
            pw[3] = (u32x4){pk2(p1[8], p1[9]), pk2(p1[10], p1[11]), pk2(p1[12], p1[13]), pk2(p1[14], p1[15])};
            const LAS unsigned char* vb = X.lds + VT_OFF + buf * TILEB + r32 * 144 + hi * 8;
#pragma unroll
            for (int kb4 = 0; kb4 < 4; ++kb4) {
                const s16x4 a0l = *(const LAS s16x4*)(vb + kb4 * 32), a0h = *(const LAS s16x4*)(vb + kb4 * 32 + 16);
                const s16x4 a1l = *(const LAS s16x4*)(vb + 32 * 144 + kb4 * 32), a1h = *(const LAS s16x4*)(vb + 32 * 144 + kb4 * 32 + 16);
                const bf16x8 a0 = (bf16x8){a0l[0], a0l[1], a0l[2], a0l[3], a0h[0], a0h[1], a0h[2], a0h[3]};
                const bf16x8 a1 = (bf16x8){a1l[0], a1l[1], a1l[2], a1l[3], a1h[0], a1h[1], a1h[2], a1h[3]};
                const bf16x8 pf = __builtin_bit_cast(bf16x8, pw[kb4]);
                o0 = __builtin_amdgcn_mfma_f32_32x32x16_bf16(a0, pf, o0, 0, 0, 0);
                o1 = __builtin_amdgcn_mfma_f32_32x32x16_bf16(a1, pf, o1, 0, 0, 0);
            }
        }
        if (tau + 1 < 12) ATT_LSTORE(buf ^ 1);
        __syncthreads();
        buf ^= 1;
    }
#undef ATT_GLOAD
#undef ATT_LSTORE
    lrun += __shfl_xor(lrun, 32);
    const float inv = 1.f / lrun; float ss = 0.f;
#pragma unroll
    for (int r = 0; r < 16; ++r) { o0[r] *= inv; o1[r] *= inv; ss += o0[r] * o0[r] + o1[r] * o1[r]; }
    ss += __shfl_xor(ss, 32);
    const float rs = 1.f / sqrtf(ss * (1.f / 64.f) + LN_EPS);
    bf16_t* orow = mix + qrow * DM + h * 64;
#pragma unroll
    for (int rg = 0; rg < 4; ++rg) {
        const int d = 8 * rg + 4 * hi;
        const f32x4 g0 = *(const f32x4*)(again + h * 64 + d), g1 = *(const f32x4*)(again + h * 64 + 32 + d);
        u32x2 w0, w1;
        w0.x = pk2(o0[4 * rg + 0] * rs * g0[0], o0[4 * rg + 1] * rs * g0[1]); w0.y = pk2(o0[4 * rg + 2] * rs * g0[2], o0[4 * rg + 3] * rs * g0[3]);
        w1.x = pk2(o1[4 * rg + 0] * rs * g1[0], o1[4 * rg + 1] * rs * g1[1]); w1.y = pk2(o1[4 * rg + 2] * rs * g1[2], o1[4 * rg + 3] * rs * g1[3]);
        *(u32x2*)(orow + d) = w0; *(u32x2*)(orow + 32 + d) = w1;
    }
}

__device__ __forceinline__ void hgrnA_unit(const Ctx& X, int b, int h, int n, bf16_t* qb, const float* gl, const bf16_t* ib, float* ointra, bf16_t* U, float* adec) {
    constexpr int QS = 0, KS = 17408, K2T = 34816, IT = 53248, SC = 71680, SEG = 80896;
    LAS bf16_t* Qs = (LAS bf16_t*)(X.lds + QS); LAS bf16_t* Ks = (LAS bf16_t*)(X.lds + KS); LAS bf16_t* K2t = (LAS bf16_t*)(X.lds + K2T);
    LAS bf16_t* It = (LAS bf16_t*)(X.lds + IT); LAS bf16_t* Sc = (LAS bf16_t*)(X.lds + SC); LAS float* segsum = (LAS float*)(X.lds + SEG);
    const int tid = X.tid, lane = X.lane, wave = X.wave, fr = lane & 15, fq = lane >> 4;
    const size_t row0 = (size_t)b * SEQ + n * 64; const int cid = (b * 8 + h) * 32 + n;
    const int d4 = (tid & 31) * 4, ts = tid >> 5;
    f32x4 g[4], bb[4]; u32x2 qraw[4];
#pragma unroll
    for (int i = 0; i < 4; ++i) { const size_t ro = (row0 + 4 * ts + i) * AWID + h * 128 + d4; g[i] = *(const f32x4*)(gl + ro); qraw[i] = *(const u32x2*)(qb + ro); }
    u32x4 iv[2];
#pragma unroll
    for (int k = 0; k < 2; ++k) { const int p = tid + NTHR * k, s_ = p & 63, ch = p >> 6; iv[k] = *(const u32x4*)(ib + (row0 + s_) * AWID + h * 128 + ch * 8); }
    f32x4 run = (f32x4){0.f, 0.f, 0.f, 0.f};
#pragma unroll
    for (int i = 0; i < 4; ++i) { run += g[i]; bb[i] = run; }
    *(LAS f32x4*)(segsum + ts * 128 + d4) = run;
#pragma unroll
    for (int k = 0; k < 2; ++k) {
        const int p = tid + NTHR * k, s_ = p & 63, ch = p >> 6; const u32x4 v = iv[k];
        LAS bf16_t* it_ = It + (ch * 8) * 72 + s_;
        it_[0 * 72] = (bf16_t)(v.x & 0xffffu); it_[1 * 72] = (bf16_t)(v.x >> 16); it_[2 * 72] = (bf16_t)(v.y & 0xffffu); it_[3 * 72] = (bf16_t)(v.y >> 16);
        it_[4 * 72] = (bf16_t)(v.z & 0xffffu); it_[5 * 72] = (bf16_t)(v.z >> 16); it_[6 * 72] = (bf16_t)(v.w & 0xffffu); it_[7 * 72] = (bf16_t)(v.w >> 16);
    }
    __syncthreads();
    f32x4 off = (f32x4){0.f, 0.f, 0.f, 0.f}, tot = off;
#pragma unroll
    for (int s_ = 0; s_ < 16; ++s_) { const f32x4 v = *(const LAS f32x4*)(segsum + s_ * 128 + d4); tot += v; if (s_ < ts) off += v; }
    f32x4 etot;
#pragma unroll
    for (int j = 0; j < 4; ++j) etot[j] = fast_exp(tot[j]);
    f32x4 k2[4];
#pragma unroll
    for (int i = 0; i < 4; ++i) {
        const int t = 4 * ts + i; const f32x4 bv = bb[i] + off; f32x4 qt, kt;
        const float q0 = bflo(qraw[i].x), q1 = bfhi(qraw[i].x), q2 = bflo(qraw[i].y), q3 = bfhi(qraw[i].y);
        qt[0] = q0 * fast_exp(bv[0]); qt[1] = q1 * fast_exp(bv[1]); qt[2] = q2 * fast_exp(bv[2]); qt[3] = q3 * fast_exp(bv[3]);
#pragma unroll
        for (int j = 0; j < 4; ++j) { const float kk = 1.f - fast_exp(g[i][j]); kt[j] = kk * fast_exp(-bv[j]); k2[i][j] = kt[j] * etot[j]; }
        u32x2 wq_, wk_; wq_.x = pk2(qt[0], qt[1]); wq_.y = pk2(qt[2], qt[3]); wk_.x = pk2(kt[0], kt[1]); wk_.y = pk2(kt[2], kt[3]);
        *(LAS u32x2*)(Qs + t * 136 + d4) = wq_; *(u32x2*)(qb + (row0 + t) * AWID + h * 128 + d4) = wq_;
        *(LAS u32x2*)(Ks + t * 136 + d4) = wk_;
    }
#pragma unroll
    for (int j = 0; j < 4; ++j) { u32x2 w; w.x = pk2(k2[0][j], k2[1][j]); w.y = pk2(k2[2][j], k2[3][j]); *(LAS u32x2*)(K2t + (d4 + j) * 72 + 4 * ts) = w; }
    if (ts == 0) *(f32x4*)(adec + (size_t)cid * 128 + d4) = etot;
    __syncthreads();
    {
        const int sb = wave >> 1;
#pragma unroll
        for (int k = 0; k < 2; ++k) {
            const int tb = (wave & 1) * 2 + k; f32x4 acc = (f32x4){0.f, 0.f, 0.f, 0.f};
            if (tb >= sb) {
                acc = mma16<128>(Ks + sb * 16 * 136, 136, Qs + tb * 16 * 136, 136, fr, fq, acc);
                const int t_ = 16 * tb + fr, s_ = 16 * sb + 4 * fq;
#pragma unroll
                for (int j = 0; j < 4; ++j) if (s_ + j > t_) acc[j] = 0.f;
            }
            u32x2 w; w.x = pk2(acc[0], acc[1]); w.y = pk2(acc[2], acc[3]);
            *(LAS u32x2*)(Sc + (16 * tb + fr) * 72 + 16 * sb + 4 * fq) = w;
        }
    }
    __syncthreads();
    {
        const int tb = wave & 3;
#pragma unroll
        for (int k = 0; k < 4; ++k) {
            const int eb = (wave >> 2) * 4 + k; f32x4 acc = (f32x4){0.f, 0.f, 0.f, 0.f};
            acc = mma16<64>(It + eb * 16 * 72, 72, Sc + tb * 16 * 72, 72, fr, fq, acc);
            *(f32x4*)(ointra + (row0 + 16 * tb + fr) * AWID + h * 128 + 16 * eb + 4 * fq) = acc;
        }
    }
    {
        bf16_t* Uc = U + (size_t)cid * 16384;
#pragma unroll
        for (int eb = 0; eb < 8; ++eb) {
            f32x4 acc = (f32x4){0.f, 0.f, 0.f, 0.f};
            acc = mma16<64>(K2t + wave * 16 * 72, 72, It + eb * 16 * 72, 72, fr, fq, acc);
            u32x2 w; w.x = pk2(acc[0], acc[1]); w.y = pk2(acc[2], acc[3]);
            *(u32x2*)(Uc + (16 * eb + fr) * 128 + 16 * wave + 4 * fq) = w;
        }
    }
    __syncthreads();
}

__device__ __forceinline__ void ph_scan(const Ctx& X, const bf16_t* U, const float* adec, bf16_t* Sp) {
    for (int item = blockIdx.x; item < 256; item += gridDim.x) {
        const int bh = item >> 3, sl = item & 7, e = sl * 16 + (X.tid >> 5), d4 = (X.tid & 31) * 4;
        f32x4 S = (f32x4){0.f, 0.f, 0.f, 0.f};
#pragma unroll 4
        for (int n = 0; n < 32; ++n) {
            const int cid = bh * 32 + n; const size_t off = (size_t)cid * 16384 + e * 128 + d4;
            u32x2 w; w.x = pk2(S[0], S[1]); w.y = pk2(S[2], S[3]);
            *(u32x2*)(Sp + off) = w;
            const u32x2 uu = *(const u32x2*)(U + off); const f32x4 a = *(const f32x4*)(adec + (size_t)cid * 128 + d4);
            S[0] = a[0] * S[0] + bflo(uu.x); S[1] = a[1] * S[1] + bfhi(uu.x); S[2] = a[2] * S[2] + bflo(uu.y); S[3] = a[3] * S[3] + bfhi(uu.y);
        }
    }
}

__device__ __forceinline__ void hgrnC_unit(const Ctx& X, int b, int h, int n, const bf16_t* qb, const bf16_t* Sp, const float* ointra, const bf16_t* gb, const float* gng, bf16_t* mix) {
    constexpr int SS = 0, QS = 34816, SSQ = 52224;
    LAS bf16_t* Ss = (LAS bf16_t*)(X.lds + SS); LAS bf16_t* Qs = (LAS bf16_t*)(X.lds + QS); LAS float* ssq = (LAS float*)(X.lds + SSQ);
    const int tid = X.tid, lane = X.lane, wave = X.wave, fr = lane & 15, fq = lane >> 4;
    const size_t row0 = (size_t)b * SEQ + n * 64; const int cid = (b * 8 + h) * 32 + n;
#pragma unroll
    for (int k = 0; k < 4; ++k) { const int p = tid + NTHR * k, e = p >> 4, ch = p & 15; *(LAS u32x4*)(Ss + e * 136 + ch * 8) = *(const u32x4*)(Sp + (size_t)cid * 16384 + e * 128 + ch * 8); }
#pragma unroll
    for (int k = 0; k < 2; ++k) { const int p = tid + NTHR * k, t = p >> 4, ch = p & 15; *(LAS u32x4*)(Qs + t * 136 + ch * 8) = *(const u32x4*)(qb + (row0 + t) * AWID + h * 128 + ch * 8); }
    __syncthreads();
    const int tb = wave & 3, eh = wave >> 2; const size_t row = row0 + 16 * tb + fr;
    f32x4 acc[4]; float ss = 0.f;
#pragma unroll
    for (int k = 0; k < 4; ++k) {
        const int eb = eh * 4 + k;
        acc[k] = *(const f32x4*)(ointra + row * AWID + h * 128 + 16 * eb + 4 * fq);
        acc[k] = mma16<128>(Ss + eb * 16 * 136, 136, Qs + tb * 16 * 136, 136, fr, fq, acc[k]);
        ss += (acc[k][0] * acc[k][0] + acc[k][1] * acc[k][1]) + (acc[k][2] * acc[k][2] + acc[k][3] * acc[k][3]);
    }
    ss += __shfl_xor(ss, 16); ss += __shfl_xor(ss, 32);
    if (fq == 0) ssq[eh * 64 + 16 * tb + fr] = ss;
    __syncthreads();
    const float tot = ssq[16 * tb + fr] + ssq[64 + 16 * tb + fr], rs = 1.f / sqrtf(tot * (1.f / 128.f) + LN_EPS);
#pragma unroll
    for (int k = 0; k < 4; ++k) {
        const int e0 = 16 * (eh * 4 + k) + 4 * fq;
        const f32x4 gg = *(const f32x4*)(gng + e0); const u32x2 sg = *(const u32x2*)(gb + row * AWID + h * 128 + e0);
        u32x2 w;
        w.x = pk2(acc[k][0] * rs * gg[0] * bflo(sg.x), acc[k][1] * rs * gg[1] * bfhi(sg.x));
        w.y = pk2(acc[k][2] * rs * gg[2] * bflo(sg.y), acc[k][3] * rs * gg[3] * bfhi(sg.y));
        *(u32x2*)(mix + row * DM + 1024 + h * 128 + e0) = w;
    }
    __syncthreads();
}

__device__ __forceinline__ void ph_rows1(const Ctx& X, const float* y1, const float* ln_g, const float* ln_b, const float* modf, float* x1, bf16_t* h2) {
    LAS float* tab = (LAS float*)X.lds;
    for (int rb = blockIdx.x; rb < 256; rb += gridDim.x) {
        const int batch = rb >> 6;
        for (int i = X.tid; i < 2048; i += NTHR) { tab[i] = ln_g[i]; tab[2048 + i] = ln_b[i]; tab[4096 + i] = 1.f + modf[(size_t)batch * NMOD + 4 * DM + i]; tab[6144 + i] = modf[(size_t)batch * NMOD + 3 * DM + i]; }
        __syncthreads();
        for (int r = X.wave; r < 32; r += 8) {
            const size_t row = (size_t)rb * 32 + r; const float* yr = y1 + row * DM + 4 * X.lane;
            f32x4 v[8];
#pragma unroll
            for (int j = 0; j < 8; ++j) v[j] = *(const f32x4*)(yr + 256 * j);
            ln_norm8(v);
            float* xr = x1 + row * DM + 4 * X.lane;
#pragma unroll
            for (int j = 0; j < 8; ++j) { const int c = 4 * X.lane + 256 * j; v[j] = v[j] * *(const LAS f32x4*)(tab + c) + *(const LAS f32x4*)(tab + 2048 + c); *(f32x4*)(xr + 256 * j) = v[j]; }
            ln_norm8(v);
            bf16_t* hr = h2 + row * DM + 4 * X.lane;
#pragma unroll
            for (int j = 0; j < 8; ++j) { const int c = 4 * X.lane + 256 * j; const f32x4 o = v[j] * *(const LAS f32x4*)(tab + 4096 + c) + *(const LAS f32x4*)(tab + 6144 + c);
                u32x2 w; w.x = pk2(o[0], o[1]); w.y = pk2(o[2], o[3]); *(u32x2*)(hr + 256 * j) = w; }
        }
        __syncthreads();
    }
}
__device__ __forceinline__ void ph_rows2(const Ctx& X, float* y2, const float* ln_g, const float* ln_b) {
    LAS float* tab = (LAS float*)X.lds;
    for (int i = X.tid; i < 2048; i += NTHR) { tab[i] = ln_g[i]; tab[2048 + i] = ln_b[i]; }
    __syncthreads();
    for (int row = blockIdx.x * 8 + X.wave; row < MROWS; row += gridDim.x * 8) {
        float* yr = y2 + (size_t)row * DM + 4 * X.lane;
        f32x4 v[8];
#pragma unroll
        for (int j = 0; j < 8; ++j) v[j] = *(const f32x4*)(yr + 256 * j);
        ln_norm8(v);
#pragma unroll
        for (int j = 0; j < 8; ++j) { const int c = 4 * X.lane + 256 * j; *(f32x4*)(yr + 256 * j) = v[j] * *(const LAS f32x4*)(tab + c) + *(const LAS f32x4*)(tab + 2048 + c); }
    }
    __syncthreads();
}

#define XB_TMO      128
#define XB_XCNT(j)  (256  + 64 * (j))
#define XB_XSUB(j)  (1280 + 64 * (j))
#define XB_XGEN(j)  (2304 + 64 * (j))
#define XB_TOP      3328
#define XB_TOPGEN   3392
#define XCD_BAR_WORDS 3456
#define XB_SPIN_CAP (1u << 18)

__device__ __forceinline__ unsigned xb_ld(unsigned* p)              { return __hip_atomic_load(p, __ATOMIC_RELAXED, __HIP_MEMORY_SCOPE_AGENT); }
__device__ __forceinline__ unsigned xb_add(unsigned* p, unsigned v) { return __hip_atomic_fetch_add(p, v, __ATOMIC_RELAXED, __HIP_MEMORY_SCOPE_AGENT); }
__device__ __forceinline__ unsigned xb_xcc_id() { return (unsigned)__builtin_amdgcn_s_getreg((3 << 11) | 20) & 0xFu; }
#define XB_SPIN(cond, bar) do { unsigned _sp = 0; while (cond) { __builtin_amdgcn_s_sleep(1); \
    if ((++_sp & 255u) == 0u) { if (xb_ld(&(bar)[XB_TMO])) break; if (_sp > XB_SPIN_CAP) { atomicAdd(&(bar)[XB_TMO], 1u); break; } } } } while (0)

struct XcdBarrier {
    unsigned* bar; unsigned x;
    volatile LAS unsigned* st;
};

__device__ __forceinline__ XcdBarrier xcd_barrier_post(unsigned* bar, volatile LAS unsigned* st) {
    XcdBarrier b; b.bar = bar; b.x = xb_xcc_id(); b.st = st;
    if (threadIdx.x == 0) (void)xb_add(&bar[XB_XCNT(b.x)], 1u);
    return b;
}
__device__ __forceinline__ void xcd_barrier_complete(unsigned* bar, unsigned x, unsigned& nloc, unsigned& nx) {
    const unsigned G = gridDim.x * gridDim.y * gridDim.z;
    unsigned sum, cnt, mine, sp = 0u;
    for (;;) {
        sum = 0u; cnt = 0u; mine = 0u;
#pragma unroll
        for (unsigned j = 0; j < 16; ++j) { const unsigned c = xb_ld(&bar[XB_XCNT(j)]); sum += c; cnt += (c > 0u) ? 1u : 0u; mine = (j == x) ? c : mine; }
        if (sum == G) break;
        __builtin_amdgcn_s_sleep(1);
        if ((++sp & 255u) == 0u) { if (xb_ld(&bar[XB_TMO])) break; if (sp > XB_SPIN_CAP) { atomicAdd(&bar[XB_TMO], 1u); break; } }
    }
    nloc = mine > 0u ? mine : 1u; nx = cnt > 0u ? cnt : 1u;
}

__device__ __forceinline__ void xcd_barrier(const XcdBarrier& b) {
    asm volatile("s_waitcnt vmcnt(0)" ::: "memory");
    __syncthreads();
    if (threadIdx.x == 0) {
        unsigned* bar = b.bar;
        __builtin_amdgcn_s_waitcnt(0);
        unsigned nloc = b.st[0], nx = b.st[1];
        if (nloc == 0u) { xcd_barrier_complete(bar, b.x, nloc, nx); b.st[0] = nloc; b.st[1] = nx; }
        const unsigned old = xb_add(&bar[XB_XSUB(b.x)], 1u);
        const unsigned gen = old / nloc;
        if (old + 1u == (gen + 1u) * nloc) {
            __builtin_amdgcn_fence(__ATOMIC_RELEASE, "agent");
            asm volatile("s_waitcnt vmcnt(0)" ::: "memory");
            const unsigned og = xb_add(&bar[XB_TOP], 1u);
            const unsigned tg = og / nx;
            if (og + 1u == (tg + 1u) * nx) xb_add(&bar[XB_TOPGEN], 1u);
            else XB_SPIN(xb_ld(&bar[XB_TOPGEN]) == tg, bar);
            __builtin_amdgcn_fence(__ATOMIC_ACQUIRE, "agent");
            xb_add(&bar[XB_XGEN(b.x)], 1u);
            asm volatile("s_waitcnt vmcnt(0)" ::: "memory");
        } else {
            XB_SPIN(xb_ld(&bar[XB_XGEN(b.x)]) == gen, bar);
            __builtin_amdgcn_fence(__ATOMIC_ACQUIRE, "agent");
            asm volatile("s_waitcnt vmcnt(0)" ::: "memory");
        }
    }
    __syncthreads();
}

constexpr int N_PHASES = 11;
constexpr int BAR_LDS_OFF = 131072 + 64;
constexpr size_t CTL_ZERO_BYTES = 16384;
#ifndef MK_PER_PHASE
#define MK_PER_PHASE 0
#endif
#ifndef PROBE_PHASE
#define PROBE_PHASE -1
#endif
#define REP(k) for (int rep_ = 0; rep_ < ((PROBE_PHASE == (k)) ? 2 : 1); ++rep_)
__device__ __forceinline__ bool ph_in(int lo, int hi, int k) { asm volatile("" : "+s"(lo), "+s"(hi)); return lo <= k && k < hi; }
__global__ void __launch_bounds__(NTHR, 2) mk_fwd(Args a) {
    extern __shared__ __attribute__((aligned(16))) unsigned char lds_raw[];
    Ctx X; X.lds = (LAS unsigned char*)lds_raw; X.tid = threadIdx.x; X.lane = X.tid & 63; X.wave = __builtin_amdgcn_readfirstlane(X.tid >> 6);
    unsigned char* ws = a.ws;
    const float *x = a.in[0], *c = a.in[1], *w_ada = a.in[2], *b_ada = a.in[3], *w_in = a.in[4], *rel_bias = a.in[5], *attn_g = a.in[6], *lb_logits = a.in[7], *gnorm_g = a.in[8],
                *w_o = a.in[9], *ln1_g = a.in[10], *ln1_b = a.in[11], *w_fi = a.in[12], *w_fo = a.in[13], *ln2_g = a.in[14], *ln2_b = a.in[15];
    float* modp = (float*)(ws + WS_MODP); float* modf = (float*)(ws + WS_MODF);
    bf16_t *win_t = (bf16_t*)(ws + WS_WIN), *wo_t = (bf16_t*)(ws + WS_WO), *wfi_t = (bf16_t*)(ws + WS_WFI), *wfo_t = (bf16_t*)(ws + WS_WFO);
    float* adec = (float*)(ws + WS_ADEC);
    bf16_t* hbuf = (bf16_t*)(ws + WS_H); float* ointra = (float*)(ws + WS_H);
    bf16_t *qa = (bf16_t*)(ws + WS_QA), *ka = (bf16_t*)(ws + WS_KA), *va = (bf16_t*)(ws + WS_VA), *qb = (bf16_t*)(ws + WS_QB), *ib = (bf16_t*)(ws + WS_IB), *gb = (bf16_t*)(ws + WS_GB);
    float* gl = (float*)(ws + WS_GL);
    bf16_t *mix = (bf16_t*)(ws + WS_MIX), *U = (bf16_t*)(ws + WS_U), *Sp = (bf16_t*)(ws + WS_SP), *uff = (bf16_t*)(ws + WS_UFF);
    float *y1 = (float*)(ws + WS_Y1), *x1 = (float*)(ws + WS_X1);
#if MK_PER_PHASE
#define IN(k) ph_in(a.ph_lo, a.ph_hi, (k))
#define SEAM(k) do { } while (0)
#else
#define IN(k) true
#define SEAM(k) xcd_barrier(bar)
    if (X.tid < 2) ((volatile LAS unsigned*)(X.lds + BAR_LDS_OFF))[X.tid] = 0u;
    __syncthreads();
    XcdBarrier bar = xcd_barrier_post((unsigned*)ws, (volatile LAS unsigned*)(X.lds + BAR_LDS_OFF));
    if (a.ph_lo == 0x7fffffff) cg::this_grid().sync();
#endif

    if (IN(0)) { ph_mod_partial(X, c, w_ada, modp); }
#if PROBE_PHASE == 0
    ph_mod_partial(X, c, w_ada, modp);
#endif
    SEAM(0);
    if (IN(1)) { ph_h1(X, x, modp, b_ada, hbuf); ph_modf(X, modp, b_ada, modf); ph_weights(X, w_in, w_o, w_fi, w_fo, win_t, wo_t, wfi_t, wfo_t); }
#if PROBE_PHASE == 1
    __syncthreads(); ph_h1(X, x, modp, b_ada, hbuf);
#endif
#if PROBE_PHASE == 11
    __syncthreads(); ph_weights(X, w_in, w_o, w_fi, w_fo, win_t, wo_t, wfi_t, wfo_t);
#endif
    SEAM(1);
    if (IN(2)) {
        pg8::Gemm g{hbuf, win_t, MROWS, NIN, DM}; pg8::StaticOrder S; S.init(MROWS, NIN, (int)gridDim.x, (int)blockIdx.x);
        EpiInProj E{qa, ka, va, qb, ib, gb, gl, lb_logits};
        pg8::gemm_phase<EpiInProj, pg8::StaticOrder, true, true>(X.lds, g, S, E);
    }
#if PROBE_PHASE == 2
    {
        pg8::Gemm g{hbuf, win_t, MROWS, NIN, DM}; pg8::StaticOrder S; S.init(MROWS, NIN, (int)gridDim.x, (int)blockIdx.x);
        EpiInProj E{qa, ka, va, qb, ib, gb, gl, lb_logits};
        pg8::gemm_phase<EpiInProj, pg8::StaticOrder, true, true>(X.lds, g, S, E);
    }
#endif
    SEAM(2);
    if (IN(3)) {
        __syncthreads();
        REP(30) for (int u = blockIdx.x; u < 512; u += gridDim.x) { const int c4 = u & 7, bh = u >> 3; attn_unit(X, bh >> 4, bh & 15, c4, qa, ka, va, rel_bias, attn_g, mix); }
        for (int u = blockIdx.x; u < 1024; u += gridDim.x) { const int n = u & 31, bh = u >> 5; hgrnA_unit(X, bh >> 3, bh & 7, n, qb, gl, ib, ointra, U, adec); }
    } SEAM(3);
    if (IN(4)) { ph_scan(X, U, adec, Sp); }
#if PROBE_PHASE == 4
    ph_scan(X, U, adec, Sp);
#endif
    SEAM(4);
    if (IN(5)) REP(5) {
        for (int u = blockIdx.x; u < 1024; u += gridDim.x) { const int n = u & 31, bh = u >> 5; hgrnC_unit(X, bh >> 3, bh & 7, n, qb, Sp, ointra, gb, gnorm_g, mix); }
    } SEAM(5);
    if (IN(6)) {
        pg8::Gemm g{mix, wo_t, MROWS, DM, DM}; pg8::StaticOrder S; S.init(MROWS, DM, (int)gridDim.x, (int)blockIdx.x);
        EpiResid E{x, modf + 2 * DM, y1};
        pg8::gemm_phase<EpiResid, pg8::StaticOrder, true, true>(X.lds, g, S, E);
    }
#if PROBE_PHASE == 6
    {
        pg8::Gemm g{mix, wo_t, MROWS, DM, DM}; pg8::StaticOrder S; S.init(MROWS, DM, (int)gridDim.x, (int)blockIdx.x);
        EpiResid E{x, modf + 2 * DM, y1};
        pg8::gemm_phase<EpiResid, pg8::StaticOrder, true, true>(X.lds, g, S, E);
    }
#endif
    SEAM(6);
    if (IN(7)) { __syncthreads(); ph_rows1(X, y1, ln1_g, ln1_b, modf, x1, hbuf); }
#if PROBE_PHASE == 7
    ph_rows1(X, y1, ln1_g, ln1_b, modf, x1, hbuf);
#endif
    SEAM(7);
    if (IN(8)) {
        pg8::Gemm g{hbuf, wfi_t, MROWS, NFF2, DM}; pg8::StaticOrder S; S.init(MROWS, NFF2, (int)gridDim.x, (int)blockIdx.x);
        EpiSwiglu E{uff};
        pg8::gemm_phase<EpiSwiglu, pg8::StaticOrder, true, true>(X.lds, g, S, E);
    }
#if PROBE_PHASE == 8
    {
        pg8::Gemm g{hbuf, wfi_t, MROWS, NFF2, DM}; pg8::StaticOrder S; S.init(MROWS, NFF2, (int)gridDim.x, (int)blockIdx.x);
        EpiSwiglu E{uff};
        pg8::gemm_phase<EpiSwiglu, pg8::StaticOrder, true, true>(X.lds, g, S, E);
    }
#endif
    SEAM(8);
    if (IN(9)) {
        pg8::Gemm g{uff, wfo_t, MROWS, DM, DFF}; pg8::StaticOrder S; S.init(MROWS, DM, (int)gridDim.x, (int)blockIdx.x);
        EpiResid E{x1, modf + 5 * DM, a.out};
        pg8::gemm_phase<EpiResid, pg8::StaticOrder, true, true>(X.lds, g, S, E);
    }
#if PROBE_PHASE == 9
    {
        pg8::Gemm g{uff, wfo_t, MROWS, DM, DFF}; pg8::StaticOrder S; S.init(MROWS, DM, (int)gridDim.x, (int)blockIdx.x);
        EpiResid E{x1, modf + 5 * DM, a.out};
        pg8::gemm_phase<EpiResid, pg8::StaticOrder, true, true>(X.lds, g, S, E);
    }
#endif
    SEAM(9);
    if (IN(10)) { __syncthreads(); ph_rows2(X, a.out, ln2_g, ln2_b); }
#undef IN
#undef SEAM
}

#ifndef MK_PER_PHASE
#define MK_PER_PHASE 0
#endif
extern "C" void kernel_launch(void* const* d_in, const int* in_sizes, int n_in, void* d_out, int out_size, void* d_ws, size_t ws_size, hipStream_t stream) {
    static int grid = 0;
    if (grid == 0) {
        if (n_in != 16 || in_sizes[0] != MROWS * DM || out_size != MROWS * DM || ws_size < WS_END) {
            fprintf(stderr, "kernel_launch: unexpected shapes (n_in %d, in0 %d, out %d, ws %zu; need ws >= %zu); nothing launched\n", n_in, n_in > 0 ? in_sizes[0] : -1, out_size, ws_size, (size_t)WS_END); grid = -1; return; }
        int dev = 0, cus = 0, per_cu = 0;
        hipGetDevice(&dev); hipDeviceGetAttribute(&cus, hipDeviceAttributeMultiprocessorCount, dev);
        if (hipFuncSetAttribute((const void*)mk_fwd, hipFuncAttributeMaxDynamicSharedMemorySize, LDS_BYTES) != hipSuccess) { fprintf(stderr, "kernel_launch: hipFuncSetAttribute failed\n"); grid = -1; return; }
        if (hipOccupancyMaxActiveBlocksPerMultiprocessor(&per_cu, (const void*)mk_fwd, NTHR, LDS_BYTES) != hipSuccess || per_cu < 1) { fprintf(stderr, "kernel_launch: occupancy query says %d blocks per CU\n", per_cu); (void)hipGetLastError(); grid = -1; return; }
        grid = cus;
    }
    if (grid < 0) return;
    Args a{};
    for (int i = 0; i < 16; ++i) a.in[i] = (const float*)d_in[i];
    a.out = (float*)d_out; a.ws = (unsigned char*)d_ws;
#if MK_PER_PHASE
    for (int p = 0; p < N_PHASES; ++p) {
        a.ph_lo = p; a.ph_hi = p + 1; void* args[] = {&a};
        hipError_t e = hipLaunchCooperativeKernel((const void*)mk_fwd, dim3(grid), dim3(NTHR), args, LDS_BYTES, stream);
        if (e != hipSuccess) { fprintf(stderr, "kernel_launch: launch %d failed: %s\n", p, hipGetErrorString(e)); break; }
    }
#else
    if (hipMemsetAsync(d_ws, 0, CTL_ZERO_BYTES, stream) != hipSuccess) { fprintf(stderr, "kernel_launch: memset of the barrier words failed\n"); return; }
    a.ph_lo = 0; a.ph_hi = N_PHASES; void* args[] = {&a};
    hipError_t e = hipLaunchCooperativeKernel((const void*)mk_fwd, dim3(grid), dim3(NTHR), args, LDS_BYTES, stream);
    if (e != hipSuccess) fprintf(stderr, "kernel_launch: cooperative launch failed: %s (grid %d)\n", hipGetErrorString(e), grid);
#endif
}
```

```cpp
#include <hip/hip_runtime.h>
#include <hip/hip_cooperative_groups.h>
#include <cstdio>
#include <cstdint>
namespace cg = cooperative_groups;
namespace pg8 {
#define PG8_LAS __attribute__((address_space(3)))
typedef unsigned short bf16_t;
typedef short bf16x8 __attribute__((ext_vector_type(8)));
typedef float f32x4 __attribute__((ext_vector_type(4)));
typedef unsigned u32x4 __attribute__((ext_vector_type(4)));
constexpr int BM = 256, BK = 64, HALF = 128, HTB = HALF * BK * 2  , STAGE_BYTES = 8 * HTB, NXCD = 8, WGM = 8;

__host__ __device__ __forceinline__ int lds_byte(int r, int c) { const int st = (r >> 4) * 2 + (c >> 5), rr = r & 15, cc = c & 31, ob = rr * 64 + cc * 2; return st * 1024 + (ob ^ (((ob >> 9) & 1) << 5)); }
__host__ __device__ __forceinline__ void stage_rc(int b, int& R, int& C) { const int st = b / 1024, sb = b % 1024, swz = sb ^ (((sb >> 9) & 1) << 5); R = (st >> 1) * 16 + swz / 64; C = (st & 1) * 32 + (swz % 64) / 2; }
__host__ __device__ __forceinline__ int perm32(int rho) { const int n = rho >> 4, i = rho & 15; return 8 * (i >> 2) + 4 * n + (i & 3); }

struct Unit { int pm, pn; };
struct Gemm { const bf16_t* A; const bf16_t* Bt; int M, N, K; };

struct StaticOrder {
    int nM, nN, nwg, G, c;
    __host__ __device__ void init(int M, int N, int G_, int c_) { nM = M / BM; nN = N / BM; nwg = nM * nN; G = G_; c = c_; }
    __host__ __device__ bool next(int i, Unit& u) const {
        const long L = (long)i * G + c; if (L >= nwg) return false;
        int wgid = (int)L; { const int q = nwg / NXCD, r = nwg % NXCD, xcd = wgid % NXCD, off = wgid / NXCD; wgid = (xcd < r ? xcd * (q + 1) : r * (q + 1) + (xcd - r) * q) + off; }
        const int nig = WGM * nN, gid = wgid / nig, fm = gid * WGM, gsz = (nM - fm) < WGM ? (nM - fm) : WGM;
        u.pm = fm + ((wgid % nig) % gsz); u.pn = (wgid % nig) / gsz; return true;
    }
    __device__ __forceinline__ void a_ready(const Unit&) const {}
    __device__ __forceinline__ void done(const Unit&) const {}
};

template <class Epi, class Sched, bool ALIGN_EPI = false, bool SP2 = false>
__device__ __forceinline__ void gemm_phase(PG8_LAS unsigned char* lds, const Gemm g, const Sched& S, const Epi& E) {
    const int tid = threadIdx.x, wid = __builtin_amdgcn_readfirstlane(tid >> 6), lane = tid & 63, wr = wid >> 2, wc = wid & 3, fr = lane & 15, fq = lane >> 4;
    const int K = g.K, nt = K / BK;
    unsigned voffA[2], voffB[2];
#pragma unroll
    for (int i = 0; i < 2; ++i) { int R, C; stage_rc(tid * 16 + i * 8192, R, C); const int Rb = Epi::PERM ? ((R & ~31) + perm32(R & 31)) : R;
        voffA[i] = (unsigned)(R * K + C) * 2u; voffB[i] = (unsigned)(Rb * K + C) * 2u; }
    const size_t kstep = (size_t)(BK * 2);
    const size_t hstep = (size_t)HALF * K * 2;
    const size_t tstep = 2 * hstep;
    const unsigned ldsw = (unsigned)wid * 1024u;
    const int aoff = lds_byte(wr * 64 + fr, fq * 8), boff = lds_byte(wc * 32 + fr, fq * 8);
#define PG8_SA(b, h) (((b) * 2 + (h)) * HTB)
#define PG8_SB(b, h) ((4 + (b) * 2 + (h)) * HTB)
#define PG8_STAGE(bufoff, gbase, voff) do { _Pragma("unroll") for (int _i = 0; _i < 2; ++_i) \
        __builtin_amdgcn_global_load_lds((const unsigned*)((const char*)(gbase) + (voff)[_i]), (PG8_LAS unsigned*)(lds + (bufoff) + ldsw + _i * 8192), 16, 0, 0); } while (0)
#define PG8_LDA(dst, b, h) do { _Pragma("unroll") for (int m = 0; m < 4; ++m) _Pragma("unroll") for (int k = 0; k < 2; ++k) dst[m][k] = *(const PG8_LAS bf16x8*)(lds + PG8_SA(b, h) + aoff + m * 2048 + k * 1024); } while (0)
#define PG8_LDB(dst, b, h) do { _Pragma("unroll") for (int n = 0; n < 2; ++n) _Pragma("unroll") for (int k = 0; k < 2; ++k) dst[n][k] = *(const PG8_LAS bf16x8*)(lds + PG8_SB(b, h) + boff + n * 2048 + k * 1024); } while (0)
#define PG8_MMA(ai, bj, At, Bt) do { __builtin_amdgcn_s_setprio(1); _Pragma("unroll") for (int m = 0; m < 4; ++m) _Pragma("unroll") for (int n = 0; n < 2; ++n) _Pragma("unroll") for (int k = 0; k < 2; ++k) \
        acc[ai][bj][m][n] = __builtin_amdgcn_mfma_f32_16x16x32_bf16(Bt[n][k], At[m][k], acc[ai][bj][m][n], 0, 0, 0); __builtin_amdgcn_s_setprio(0); } while (0)
#define PG8_WAIT_V(n) asm volatile("s_waitcnt vmcnt(" #n ")" ::: "memory")
#define PG8_WAIT_L(n) asm volatile("s_waitcnt lgkmcnt(" #n ")" ::: "memory")
#define PG8_BAR __builtin_amdgcn_s_barrier()
#define PG8_SCHED __builtin_amdgcn_sched_barrier(0)
    Unit cur, nxt; int ui = 0;
    if (!S.next(0, cur)) return;
    f32x4 acc[2][2][4][2];
#pragma unroll
    for (int a = 0; a < 2; ++a)
#pragma unroll
        for (int b = 0; b < 2; ++b)
#pragma unroll
            for (int m = 0; m < 4; ++m)
#pragma unroll
                for (int n = 0; n < 2; ++n) acc[a][b][m][n] = (f32x4){0.f, 0.f, 0.f, 0.f};
    bf16x8 At[4][2], B0[2][2], B1[2][2];
    const char* cA = (const char*)g.A + (size_t)cur.pm * tstep; const char* cB = (const char*)g.Bt + (size_t)cur.pn * tstep;
    S.a_ready(cur);
    if constexpr (SP2) {
        PG8_STAGE(PG8_SB(0, 0), cB, voffB); PG8_STAGE(PG8_SB(0, 1), cB + hstep, voffB); PG8_STAGE(PG8_SA(0, 0), cA, voffA); PG8_STAGE(PG8_SA(0, 1), cA + hstep, voffA);
        if (wr == 1) PG8_BAR;
        PG8_WAIT_V(2); PG8_BAR;
        PG8_STAGE(PG8_SB(1, 0), cB + kstep, voffB); PG8_STAGE(PG8_SA(1, 0), cA + kstep, voffA); PG8_STAGE(PG8_SB(1, 1), cB + hstep + kstep, voffB);
        PG8_WAIT_V(6); PG8_BAR;
    } else {
        PG8_STAGE(PG8_SB(0, 0), cB, voffB); PG8_STAGE(PG8_SA(0, 0), cA, voffA); PG8_STAGE(PG8_SB(0, 1), cB + hstep, voffB); PG8_STAGE(PG8_SA(0, 1), cA + hstep, voffA);
        if (wr == 1) PG8_BAR;
        PG8_WAIT_V(4); PG8_BAR;
        PG8_STAGE(PG8_SB(1, 0), cB + kstep, voffB); PG8_STAGE(PG8_SA(1, 0), cA + kstep, voffA); PG8_STAGE(PG8_SB(1, 1), cB + hstep + kstep, voffB);
        PG8_WAIT_V(6); PG8_BAR;
    }
    for (;;) {
        const bool has_next = S.next(ui + 1, nxt);
        const char* nA = has_next ? (const char*)g.A + (size_t)nxt.pm * tstep : cA; const char* nB = has_next ? (const char*)g.Bt + (size_t)nxt.pn * tstep : cB;
        for (int t = 0; t < nt; t += 2) {
            const bool last = (t == nt - 2);
            const char* a1 = cA + (size_t)(t + 1) * kstep;
            const char* a2 = last ? nA : cA + (size_t)(t + 2) * kstep; const char* b2 = last ? nB : cB + (size_t)(t + 2) * kstep;
            const char* a3 = a2 + kstep; const char* b3 = b2 + kstep;
            if (last && has_next) S.a_ready(nxt);
            if constexpr (SP2) {
            PG8_LDB(B0, 0, 0); PG8_LDB(B1, 0, 1); PG8_SCHED; PG8_LDA(At, 0, 0); PG8_STAGE(PG8_SA(1, 1), a1 + hstep, voffA);
            PG8_WAIT_V(8); PG8_WAIT_L(0); PG8_BAR; PG8_MMA(0, 0, At, B0); PG8_MMA(0, 1, At, B1); PG8_BAR; PG8_SCHED;
            PG8_LDA(At, 0, 1); PG8_STAGE(PG8_SB(0, 0), b2, voffB); PG8_STAGE(PG8_SB(0, 1), b2 + hstep, voffB); PG8_STAGE(PG8_SA(0, 0), a2, voffA);
            PG8_WAIT_V(8); PG8_WAIT_L(0); PG8_BAR; PG8_MMA(1, 0, At, B0); PG8_MMA(1, 1, At, B1); PG8_BAR; PG8_SCHED;
            PG8_LDB(B0, 1, 0); PG8_LDB(B1, 1, 1); PG8_SCHED; PG8_LDA(At, 1, 0); PG8_STAGE(PG8_SA(0, 1), a2 + hstep, voffA);
            PG8_WAIT_V(8); PG8_WAIT_L(0); PG8_BAR; PG8_MMA(0, 0, At, B0); PG8_MMA(0, 1, At, B1); PG8_BAR; PG8_SCHED;
            PG8_LDA(At, 1, 1); PG8_STAGE(PG8_SB(1, 0), b3, voffB); PG8_STAGE(PG8_SB(1, 1), b3 + hstep, voffB); PG8_STAGE(PG8_SA(1, 0), a3, voffA);
            PG8_WAIT_V(8); PG8_WAIT_L(0); PG8_BAR; PG8_MMA(1, 0, At, B0); PG8_MMA(1, 1, At, B1); PG8_BAR; PG8_SCHED;
            } else {
            PG8_LDB(B0, 0, 0); PG8_SCHED; PG8_LDA(At, 0, 0); PG8_STAGE(PG8_SA(1, 1), a1 + hstep, voffA);
            PG8_WAIT_L(8); PG8_BAR; PG8_WAIT_L(0); PG8_MMA(0, 0, At, B0); PG8_BAR; PG8_SCHED;
            PG8_LDB(B1, 0, 1); PG8_STAGE(PG8_SB(0, 0), b2, voffB);
            PG8_BAR; PG8_WAIT_L(0); PG8_MMA(0, 1, At, B1); PG8_BAR;
            PG8_LDA(At, 0, 1); PG8_STAGE(PG8_SA(0, 0), a2, voffA);
            PG8_BAR; PG8_WAIT_L(0); PG8_MMA(1, 0, At, B0); PG8_BAR; PG8_SCHED;
            PG8_STAGE(PG8_SB(0, 1), b2 + hstep, voffB);
            PG8_WAIT_V(6); PG8_BAR; PG8_MMA(1, 1, At, B1); PG8_BAR;
            PG8_LDB(B0, 1, 0); PG8_SCHED; PG8_LDA(At, 1, 0); PG8_STAGE(PG8_SA(0, 1), a2 + hstep, voffA);
            PG8_WAIT_L(8); PG8_BAR; PG8_WAIT_L(0); PG8_MMA(0, 0, At, B0); PG8_BAR; PG8_SCHED;
            PG8_LDB(B1, 1, 1); PG8_STAGE(PG8_SB(1, 0), b3, voffB);
            PG8_BAR; PG8_WAIT_L(0); PG8_MMA(0, 1, At, B1); PG8_BAR;
            PG8_LDA(At, 1, 1); PG8_STAGE(PG8_SA(1, 0), a3, voffA);
            PG8_BAR; PG8_WAIT_L(0); PG8_MMA(1, 0, At, B0); PG8_BAR; PG8_SCHED;
            PG8_STAGE(PG8_SB(1, 1), b3 + hstep, voffB);
            PG8_WAIT_V(6); PG8_BAR; PG8_MMA(1, 1, At, B1); PG8_BAR;
            }
        }
        if constexpr (ALIGN_EPI) { if (wr == 0) PG8_BAR; }
        if constexpr (!Epi::AFTER_DRAIN) { E(acc, cur, wr, wc, fr, fq); S.done(cur); }
        if (!has_next) break;
#pragma unroll
        for (int a = 0; a < 2; ++a)
#pragma unroll
            for (int b = 0; b < 2; ++b)
#pragma unroll
                for (int m = 0; m < 4; ++m)
#pragma unroll
                    for (int n = 0; n < 2; ++n) acc[a][b][m][n] = (f32x4){0.f, 0.f, 0.f, 0.f};
        cur = nxt; cA = nA; cB = nB; ++ui;
        if constexpr (ALIGN_EPI) { if (wr == 1) PG8_BAR; }
    }
    PG8_WAIT_V(0);
    if constexpr (!ALIGN_EPI) { if (wr == 0) PG8_BAR; }
    PG8_BAR;
    if constexpr (Epi::AFTER_DRAIN) { E.fused(acc, cur, wr, wc, fr, fq, lds, wid, lane); S.done(cur); }
#undef PG8_SA
#undef PG8_SB
#undef PG8_STAGE
#undef PG8_LDA
#undef PG8_LDB
#undef PG8_MMA
#undef PG8_WAIT_V
#undef PG8_WAIT_L
#undef PG8_BAR
#undef PG8_SCHED
}
}

constexpr int NB = 4, SEQ = 2048, DM = 2048, MROWS = NB * SEQ;
constexpr int NIN = 7168, DFF = 5632, NFF2 = 2 * DFF, NMOD = 6 * DM;
constexpr int AWID = 1024;
constexpr float LN_EPS = 1e-5f;
constexpr float ALPHA = 1.189207115002721f;
constexpr float LOG2E = 1.4426950408889634f;
constexpr float QSCALE = 0.125f * LOG2E;

constexpr size_t MiB = 1u << 20;
constexpr size_t WS_MODP = 364 * MiB;
constexpr size_t WS_MODF = 2 * MiB + 1572864;
constexpr size_t WS_WIN = 4 * MiB, WS_WO = 32 * MiB, WS_WFI = 40 * MiB, WS_WFO = 84 * MiB;
constexpr size_t WS_ADEC = 106 * MiB;
constexpr size_t WS_H = 108 * MiB;
constexpr size_t WS_QA = 140 * MiB, WS_KA = 156 * MiB, WS_VA = 172 * MiB, WS_QB = 188 * MiB, WS_IB = 204 * MiB, WS_GB = 220 * MiB;
constexpr size_t WS_GL = 236 * MiB;
constexpr size_t WS_MIX = 268 * MiB;
constexpr size_t WS_U = 300 * MiB, WS_SP = 332 * MiB;
constexpr size_t WS_Y1 = 140 * MiB, WS_X1 = 204 * MiB;
constexpr size_t WS_UFF = 268 * MiB;
constexpr size_t WS_END = 368 * MiB;

constexpr int LDS_BYTES = 147456;
constexpr int NTHR = 512;

#define LAS __attribute__((address_space(3)))
typedef unsigned short bf16_t;
typedef short bf16x8 __attribute__((ext_vector_type(8)));
typedef short s16x4 __attribute__((ext_vector_type(4)));
typedef float f32x4 __attribute__((ext_vector_type(4)));
typedef float f32x2 __attribute__((ext_vector_type(2)));
typedef float f32x16 __attribute__((ext_vector_type(16)));
typedef unsigned u32x4 __attribute__((ext_vector_type(4)));
typedef unsigned u32x2 __attribute__((ext_vector_type(2)));
typedef __bf16 bf16x2_t __attribute__((ext_vector_type(2)));

__device__ __forceinline__ unsigned pk2(float lo, float hi) { f32x2 v = {lo, hi}; bf16x2_t b = __builtin_convertvector(v, bf16x2_t); return __builtin_bit_cast(unsigned, b); }
__device__ __forceinline__ bf16_t f2bf(float x) { return (bf16_t)(pk2(x, 0.f) & 0xffffu); }
__device__ __forceinline__ float bf2f(unsigned v) { return __uint_as_float(v << 16); }
__device__ __forceinline__ float bflo(unsigned w) { return __uint_as_float(w << 16); }
__device__ __forceinline__ float bfhi(unsigned w) { return __uint_as_float(w & 0xffff0000u); }
__device__ __forceinline__ float fast_exp(float x) { return __builtin_amdgcn_exp2f(x * LOG2E); }
__device__ __forceinline__ float silu_f(float x) { return x * __builtin_amdgcn_rcpf(1.f + __builtin_amdgcn_exp2f(-x * LOG2E)); }
__device__ __forceinline__ float wave_sum(float v) {
#pragma unroll
    for (int o = 1; o < 64; o <<= 1) v += __shfl_xor(v, o);
    return v;
}

struct EpiInProj {
    static constexpr bool PERM = true, AFTER_DRAIN = false;
    bf16_t *qa, *ka, *va, *qb, *ib, *gb; float* gl; const float* lbl;
    __device__ __forceinline__ void operator()(const f32x4 (&acc)[2][2][4][2], const pg8::Unit& u, int wr, int wc, int fr, int fq) const {
        const int seg = u.pn >> 2; const int colt = (u.pn & 3) * 256 + wc * 32 + 8 * fq; const int row0 = u.pm * 256 + wr * 64 + fr;
        if (seg == 4) {
#pragma unroll
            for (int bj = 0; bj < 2; ++bj) {
                const int c = colt + bj * 128; float lb[8];
#pragma unroll
                for (int i = 0; i < 8; ++i) { const float l0 = lbl[c + i], l1 = lbl[1024 + c + i]; lb[i] = 1.f / (1.f + __expf(l1 - l0)); }
#pragma unroll
                for (int ai = 0; ai < 2; ++ai)
#pragma unroll
                    for (int m = 0; m < 4; ++m) {
                        float* rp = gl + (size_t)(row0 + ai * 128 + m * 16) * AWID + c; f32x4 o0, o1;
#pragma unroll
                        for (int i = 0; i < 4; ++i) {
                            const float s0 = 1.f / (1.f + __expf(-acc[ai][bj][m][0][i])), s1 = 1.f / (1.f + __expf(-acc[ai][bj][m][1][i]));
                            o0[i] = __logf(lb[i] + (1.f - lb[i]) * s0); o1[i] = __logf(lb[4 + i] + (1.f - lb[4 + i]) * s1);
                        }
                        *(f32x4*)rp = o0; *(f32x4*)(rp + 4) = o1;
                    }
            }
        } else {
            bf16_t* base = seg == 0 ? qa : seg == 1 ? ka : seg == 2 ? va : seg == 3 ? qb : seg == 5 ? ib : gb;
            const bool act = (seg == 3 || seg == 6); const float sc = seg == 0 ? QSCALE : 1.f;
#pragma unroll
            for (int ai = 0; ai < 2; ++ai)
#pragma unroll
                for (int m = 0; m < 4; ++m) {
                    bf16_t* rp = base + (size_t)(row0 + ai * 128 + m * 16) * AWID + colt;
#pragma unroll
                    for (int bj = 0; bj < 2; ++bj) {
                        f32x4 v0 = acc[ai][bj][m][0], v1 = acc[ai][bj][m][1];
                        if (act) {
#pragma unroll
                            for (int i = 0; i < 4; ++i) { v0[i] = silu_f(v0[i]); v1[i] = silu_f(v1[i]); }
                        }
                        v0 = v0 * sc; v1 = v1 * sc;
                        u32x4 w; w.x = pk2(v0[0], v0[1]); w.y = pk2(v0[2], v0[3]); w.z = pk2(v1[0], v1[1]); w.w = pk2(v1[2], v1[3]);
                        *(u32x4*)(rp + bj * 128) = w;
                    }
                }
        }
    }
};
struct EpiResid {
    static constexpr bool PERM = true, AFTER_DRAIN = false;
    const float* base; const float* gate; float* out;
    __device__ __forceinline__ void operator()(const f32x4 (&acc)[2][2][4][2], const pg8::Unit& u, int wr, int wc, int fr, int fq) const {
        const int row0 = u.pm * 256 + wr * 64 + fr, batch = u.pm >> 3, col0 = u.pn * 256 + wc * 32 + 8 * fq;
#pragma unroll
        for (int bj = 0; bj < 2; ++bj) {
            const int c = col0 + bj * 128;
            const f32x4 g0 = *(const f32x4*)(gate + (size_t)batch * NMOD + c), g1 = *(const f32x4*)(gate + (size_t)batch * NMOD + c + 4);
#pragma unroll
            for (int ai = 0; ai < 2; ++ai)
#pragma unroll
                for (int m = 0; m < 4; ++m) {
                    const size_t off = (size_t)(row0 + ai * 128 + m * 16) * DM + c;
                    const f32x4 b0 = *(const f32x4*)(base + off), b1 = *(const f32x4*)(base + off + 4);
                    *(f32x4*)(out + off) = b0 * ALPHA + g0 * acc[ai][bj][m][0];
                    *(f32x4*)(out + off + 4) = b1 * ALPHA + g1 * acc[ai][bj][m][1];
                }
        }
    }
};
struct EpiSwiglu {
    static constexpr bool PERM = true, AFTER_DRAIN = false;
    bf16_t* U;
    __device__ __forceinline__ void operator()(const f32x4 (&acc)[2][2][4][2], const pg8::Unit& u, int wr, int wc, int fr, int fq) const {
        const int row0 = u.pm * 256 + wr * 64 + fr, col0 = u.pn * 128 + wc * 32 + 8 * fq;
#pragma unroll
        for (int ai = 0; ai < 2; ++ai)
#pragma unroll
            for (int m = 0; m < 4; ++m) {
                f32x4 r0, r1;
#pragma unroll
                for (int i = 0; i < 4; ++i) { r0[i] = silu_f(acc[ai][0][m][0][i]) * acc[ai][1][m][0][i]; r1[i] = silu_f(acc[ai][0][m][1][i]) * acc[ai][1][m][1][i]; }
                u32x4 w; w.x = pk2(r0[0], r0[1]); w.y = pk2(r0[2], r0[3]); w.z = pk2(r1[0], r1[1]); w.w = pk2(r1[2], r1[3]);
                *(u32x4*)(U + (size_t)(row0 + ai * 128 + m * 16) * DFF + col0) = w;
            }
    }
};

struct Args { const float* in[16]; float* out; unsigned char* ws; int ph_lo, ph_hi; };
struct Ctx { LAS unsigned char* lds; int tid, lane, wave; };
__device__ __forceinline__ Ctx mk_ctx(LAS unsigned char* lds) { Ctx X; int t = threadIdx.x; asm volatile("" : "+v"(t)); X.lds = lds; X.tid = t; X.lane = t & 63; X.wave = __builtin_amdgcn_readfirstlane(t >> 6); return X; }

template <int K> __device__ __forceinline__ f32x4 mma16(const LAS bf16_t* A, int sa, const LAS bf16_t* Bt, int sb, int fr, int fq, f32x4 acc) {
#pragma unroll
    for (int k0 = 0; k0 < K; k0 += 32) {
        const bf16x8 a = *(const LAS bf16x8*)(A + fr * sa + k0 + 8 * fq), b = *(const LAS bf16x8*)(Bt + fr * sb + k0 + 8 * fq);
        acc = __builtin_amdgcn_mfma_f32_16x16x32_bf16(a, b, acc, 0, 0, 0);
    }
    return acc;
}

__device__ __forceinline__ void ph_mod_partial(const Ctx& X, const float* c, const float* w_ada, float* modp) {
    LAS float* red = (LAS float*)X.lds;
    for (int item = blockIdx.x; item < 768; item += gridDim.x) {
        const int ks = item / 48, cb = item % 48, k0 = ks * 128 + X.wave * 16;
        const float* wp = w_ada + (size_t)k0 * NMOD + cb * 256 + X.lane * 4;
        f32x4 w[16];
#pragma unroll
        for (int i = 0; i < 16; ++i) w[i] = __builtin_nontemporal_load((const f32x4*)(wp + (size_t)i * NMOD));
        LAS float* cvs = (LAS float*)(X.lds + 32768) + X.wave * 64;
        { const int b = X.lane >> 4; const float v = c[b * DM + k0 + (X.lane & 15)]; cvs[X.lane] = v / (1.f + __expf(-v)); }
        f32x4 acc[4];
#pragma unroll
        for (int b = 0; b < 4; ++b) acc[b] = (f32x4){0.f, 0.f, 0.f, 0.f};
#pragma unroll
        for (int i = 0; i < 16; ++i) {
#pragma unroll
            for (int b = 0; b < 4; ++b) { const float s = cvs[b * 16 + i]; acc[b] += w[i] * s; }
        }
#pragma unroll
        for (int b = 0; b < 4; ++b) *(LAS f32x4*)(red + (X.wave * 4 + b) * 256 + X.lane * 4) = acc[b];
        __syncthreads();
#pragma unroll
        for (int k = 0; k < 2; ++k) { const int o = X.tid + NTHR * k, b = o >> 8, cc = o & 255; float s = 0.f;
#pragma unroll
            for (int w8 = 0; w8 < 8; ++w8) s += red[(w8 * 4 + b) * 256 + cc];
            modp[(size_t)(ks * 4 + b) * NMOD + cb * 256 + cc] = s; }
        __syncthreads();
    }
}

__device__ __forceinline__ float mod_value(const float* modp, const float* b_ada, int batch, int mc) {
    float s = b_ada[mc];
#pragma unroll
    for (int ks = 0; ks < 16; ++ks) s += modp[(size_t)(ks * 4 + batch) * NMOD + mc];
    return s;
}
__device__ __forceinline__ void ln_norm8(f32x4 (&v)[8]) {
    float s = 0.f;
#pragma unroll
    for (int j = 0; j < 8; ++j) s += (v[j][0] + v[j][1]) + (v[j][2] + v[j][3]);
    const float mean = wave_sum(s) * (1.f / DM); float q = 0.f;
#pragma unroll
    for (int j = 0; j < 8; ++j) { v[j] = v[j] - mean; q += (v[j][0] * v[j][0] + v[j][1] * v[j][1]) + (v[j][2] * v[j][2] + v[j][3] * v[j][3]); }
    const float rstd = 1.f / sqrtf(wave_sum(q) * (1.f / DM) + LN_EPS);
#pragma unroll
    for (int j = 0; j < 8; ++j) v[j] = v[j] * rstd;
}
__device__ __forceinline__ void ph_h1(const Ctx& X, const float* x, const float* modp, const float* b_ada, bf16_t* h) {
    LAS float* tab = (LAS float*)X.lds;
    for (int rb = blockIdx.x; rb < 256; rb += gridDim.x) {
        const int batch = rb >> 6;
        for (int i = X.tid; i < 4096; i += NTHR) { const float s = mod_value(modp, b_ada, batch, i); tab[i] = (i >= 2048) ? 1.f + s : s; }
        __syncthreads();
        for (int r = X.wave; r < 32; r += 8) {
            const size_t row = (size_t)rb * 32 + r; const float* xr = x + row * DM + 4 * X.lane;
            f32x4 v[8];
#pragma unroll
            for (int j = 0; j < 8; ++j) v[j] = *(const f32x4*)(xr + 256 * j);
            ln_norm8(v);
            bf16_t* hr = h + row * DM + 4 * X.lane;
#pragma unroll
            for (int j = 0; j < 8; ++j) {
                const int c = 4 * X.lane + 256 * j; const f32x4 sh = *(const LAS f32x4*)(tab + c), sc = *(const LAS f32x4*)(tab + 2048 + c);
                const f32x4 o = v[j] * sc + sh; u32x2 w; w.x = pk2(o[0], o[1]); w.y = pk2(o[2], o[3]); *(u32x2*)(hr + 256 * j) = w;
            }
        }
        __syncthreads();
    }
}
__device__ __forceinline__ int ffi_row(int c) { const int cc = c < DFF ? c : c - DFF; return ((cc >> 7) << 8) + (c < DFF ? 0 : 128) + (cc & 127); }
__device__ __forceinline__ void transpose_item(const float* W, int K, int N, bf16_t* WT, bool ffi, LAS float* scr, int item, int lane) {
    const int nblk = N / 32, kb = item / nblk, nb = item % nblk, k0 = 64 * kb, n0 = 32 * nb;
    const int r0 = ffi ? ffi_row(n0) : n0;
    f32x4 v[8];
    const float* wp = W + (size_t)(k0 + (lane >> 3)) * N + n0 + 4 * (lane & 7);
#pragma unroll
    for (int i = 0; i < 8; ++i) v[i] = __builtin_nontemporal_load((const f32x4*)(wp + (size_t)(8 * i) * N));
#pragma unroll
    for (int i = 0; i < 8; ++i) { LAS float* d = scr + (8 * i + (lane >> 3)) * 33 + 4 * (lane & 7); d[0] = v[i][0]; d[1] = v[i][1]; d[2] = v[i][2]; d[3] = v[i][3]; }
    asm volatile("s_waitcnt lgkmcnt(0)" ::: "memory");
    const int c = lane & 7;
#pragma unroll
    for (int j = 0; j < 4; ++j) { const int n = (lane >> 3) + 8 * j; const LAS float* s = scr + (8 * c) * 33 + n;
        u32x4 o; o.x = pk2(s[0 * 33], s[1 * 33]); o.y = pk2(s[2 * 33], s[3 * 33]); o.z = pk2(s[4 * 33], s[5 * 33]); o.w = pk2(s[6 * 33], s[7 * 33]);
        *(u32x4*)(WT + (size_t)(r0 + n) * K + k0 + 8 * c) = o; }
    asm volatile("s_waitcnt lgkmcnt(0)" ::: "memory");
}
__device__ __forceinline__ void ph_weights(const Ctx& X, const float* w_in, const float* w_o, const float* w_fi, const float* w_fo, bf16_t* win_t, bf16_t* wo_t, bf16_t* wfi_t, bf16_t* wfo_t) {
    LAS float* scr = (LAS float*)(X.lds + X.wave * 16384);
    const int gw = blockIdx.x * 8 + X.wave, NGW = gridDim.x * 8;
    constexpr int I_IN = (DM / 64) * (NIN / 32), I_O = (DM / 64) * (DM / 32), I_FI = (DM / 64) * (NFF2 / 32), I_FO = (DFF / 64) * (DM / 32);
    for (int it = gw; it < I_IN + I_O + I_FI + I_FO; it += NGW) {
        int r = it;
        if (r < I_IN) { transpose_item(w_in, DM, NIN, win_t, false, scr, r, X.lane); continue; } r -= I_IN;
        if (r < I_O) { transpose_item(w_o, DM, DM, wo_t, false, scr, r, X.lane); continue; } r -= I_O;
        if (r < I_FI) { transpose_item(w_fi, DM, NFF2, wfi_t, true, scr, r, X.lane); continue; } r -= I_FI;
        transpose_item(w_fo, DFF, DM, wfo_t, false, scr, r, X.lane);
    }
}
__device__ __forceinline__ void ph_modf(const Ctx& X, const float* modp, const float* b_ada, float* modf) {
    for (int idx = blockIdx.x * NTHR + X.tid; idx < NB * NMOD; idx += gridDim.x * NTHR) { const int b = idx / NMOD, col = idx % NMOD; modf[idx] = mod_value(modp, b_ada, b, col); }
}

__device__ __forceinline__ void attn_unit(const Ctx& X, int b, int h, int c4, const bf16_t* qa, const bf16_t* ka, const bf16_t* va, const float* rel_bias, const float* again, bf16_t* mix) {
    constexpr int KS_OFF = 0, VT_OFF = 18432, TB_OFF = 36864, TILEB = 9216;
    const int lane = X.lane, wave = X.wave, tid = X.tid, r32 = lane & 31, hi = lane >> 5, wq = wave >> 1;
    const int qpos = (4 * c4 + wq) * 64 + (wave & 1) * 32 + r32;
    const size_t qrow = (size_t)b * SEQ + qpos;
    LAS float* tbr = (LAS float*)(X.lds + TB_OFF);
    for (int i = tid; i < 639; i += NTHR) { const int rel = 575 - i; tbr[i] = rel_bias[h * 513 + (rel < 256 ? rel : 256) + 256] * LOG2E; }
    bf16x8 qr[4];
#pragma unroll
    for (int d0 = 0; d0 < 4; ++d0) qr[d0] = *(const bf16x8*)(qa + qrow * AWID + h * 64 + d0 * 16 + hi * 8);
    f32x16 o0, o1;
#pragma unroll
    for (int r = 0; r < 16; ++r) { o0[r] = 0.f; o1[r] = 0.f; }
    float mrun = -1e30f, lrun = 0.f;
    const int tau_lo = (8 - 4 * c4) > 0 ? (8 - 4 * c4) : 0;
    const int krow = tid >> 3, kch = tid & 7, vrow = lane, vch = wave;
    const bf16_t* kbase = ka + ((size_t)b * SEQ + krow) * AWID + h * 64 + kch * 8;
    const bf16_t* vbase = va + ((size_t)b * SEQ + vrow) * AWID + h * 64 + vch * 8;
    u32x4 kreg, vreg;
#define ATT_GLOAD(tau) do { const long kt0_ = (long)(4 * c4 - 8 + (tau)) * 64; kreg = *(const u32x4*)(kbase + kt0_ * AWID); vreg = *(const u32x4*)(vbase + kt0_ * AWID); } while (0)
#define ATT_LSTORE(bufi) do { *(LAS u32x4*)(X.lds + KS_OFF + (bufi) * TILEB + krow * 144 + kch * 16) = kreg; \
        LAS bf16_t* vt_ = (LAS bf16_t*)(X.lds + VT_OFF + (bufi) * TILEB) + (vch * 8) * 72 + vrow; \
        vt_[0 * 72] = (bf16_t)(vreg.x & 0xffffu); vt_[1 * 72] = (bf16_t)(vreg.x >> 16); vt_[2 * 72] = (bf16_t)(vreg.y & 0xffffu); vt_[3 * 72] = (bf16_t)(vreg.y >> 16); \
        vt_[4 * 72] = (bf16_t)(vreg.z & 0xffffu); vt_[5 * 72] = (bf16_t)(vreg.z >> 16); vt_[6 * 72] = (bf16_t)(vreg.w & 0xffffu); vt_[7 * 72] = (bf16_t)(vreg.w >> 16); } while (0)
    ATT_GLOAD(tau_lo); ATT_LSTORE(0);
    __syncthreads();
    int buf = 0;
    for (int tau = tau_lo; tau < 12; ++tau) {
        if (tau + 1 < 12) ATT_GLOAD(tau + 1);
        if (tau >= wq && tau <= wq + 8) {
            f32x16 p0, p1;
#pragma unroll
            for (int r = 0; r < 16; ++r) { p0[r] = 0.f; p1[r] = 0.f; }
            const LAS unsigned char* kb = X.lds + KS_OFF + buf * TILEB + r32 * 144 + hi * 16;
#pragma unroll
            for (int d0 = 0; d0 < 4; ++d0) {
                const bf16x8 k0 = *(const LAS bf16x8*)(kb + d0 * 32), k1 = *(const LAS bf16x8*)(kb + 32 * 144 + d0 * 32);
                p0 = __builtin_amdgcn_mfma_f32_32x32x16_bf16(k0, qr[d0], p0, 0, 0, 0);
                p1 = __builtin_amdgcn_mfma_f32_32x32x16_bf16(k1, qr[d0], p1, 0, 0, 0);
            }
            const int kt0 = (4 * c4 - 8 + tau) * 64;
            const LAS float* tb = tbr + (575 - qpos + kt0 + 4 * hi);
            float mx = -1e30f;
#pragma unroll
            for (int r = 0; r < 16; ++r) { const int off = (r & 3) + 8 * (r >> 2); p0[r] += tb[off]; p1[r] += tb[off + 32]; mx = fmaxf(mx, fmaxf(p0[r], p1[r])); }
            mx = fmaxf(mx, __shfl_xor(mx, 32));
            const float mn = fmaxf(mrun, mx), al = __builtin_amdgcn_exp2f(mrun - mn); mrun = mn;
            float ls = 0.f;
#pragma unroll
            for (int r = 0; r < 16; ++r) { p0[r] = __builtin_amdgcn_exp2f(p0[r] - mn); p1[r] = __builtin_amdgcn_exp2f(p1[r] - mn); ls += p0[r] + p1[r]; }
            lrun = lrun * al + ls;
#pragma unroll
            for (int r = 0; r < 16; ++r) { o0[r] *= al; o1[r] *= al; }
            u32x4 pw[4];
            pw[0] = (u32x4){pk2(p0[0], p0[1]), pk2(p0[2], p0[3]), pk2(p0[4], p0[5]), pk2(p0[6], p0[7])};
            pw[1] = (u32x4){pk2(p0[8], p0[9]), pk2(p0[10], p0[11]), pk2(p0[12], p0[13]), pk2(p0[14], p0[15])};
            pw[2] = (u32x4){pk2(p1[0], p1[1]), pk2(p1[2], p1[3]), pk2(p1[4], p1[5]), pk2(p1[6], p1[7])};
            pw[3] = (u32x4){pk2(p1[8], p1[9]), pk2(p1[10], p1[11]), pk2(p1[12], p1[13]), pk2(p1[14], p1[15])};
            const LAS unsigned char* vb = X.lds + VT_OFF + buf * TILEB + r32 * 144 + hi * 8;
#pragma unroll
            for (int kb4 = 0; kb4 < 4; ++kb4) {
                const s16x4 a0l = *(const LAS s16x4*)(vb + kb4 * 32), a0h = *(const LAS s16x4*)(vb + kb4 * 32 + 16);
                const s16x4 a1l = *(const LAS s16x4*)(vb + 32 * 144 + kb4 * 32), a1h = *(const LAS s16x4*)(vb + 32 * 144 + kb4 * 32 + 16);
                const bf16x8 a0 = (bf16x8){a0l[0], a0l[1], a0l[2], a0l[3], a0h[0], a0h[1], a0h[2], a0h[3]};
                const bf16x8 a1 = (bf16x8){a1l[0], a1l[1], a1l[2], a1l[3], a1h[0], a1h[1], a1h[2], a1h[3]};
                const bf16x8 pf = __builtin_bit_cast(bf16x8, pw[kb4]);
                o0 = __builtin_amdgcn_mfma_f32_32x32x16_bf16(a0, pf, o0, 0, 0, 0);
                o1 = __builtin_amdgcn_mfma_f32_32x32x16_bf16(a1, pf, o1, 0, 0, 0);
            }
        }
        if (tau + 1 < 12) ATT_LSTORE(buf ^ 1);
        __syncthreads();
        buf ^= 1;
    }
#undef ATT_GLOAD
#undef ATT_LSTORE
    lrun += __shfl_xor(lrun, 32);
    const float inv = 1.f / lrun; float ss = 0.f;
#pragma unroll
    for (int r = 0; r < 16; ++r) { o0[r] *= inv; o1[r] *= inv; ss += o0[r] * o0[r] + o1[r] * o1[r]; }
    ss += __shfl_xor(ss, 32);
    const float rs = 1.f / sqrtf(ss * (1.f / 64.f) + LN_EPS);
    bf16_t* orow = mix + qrow * DM + h * 64;
#pragma unroll
    for (int rg = 0; rg < 4; ++rg) {
        const int d = 8 * rg + 4 * hi;
        const f32x4 g0 = *(const f32x4*)(again + h * 64 + d), g1 = *(const f32x4*)(again + h * 64 + 32 + d);
        u32x2 w0, w1;
        w0.x = pk2(o0[4 * rg + 0] * rs * g0[0], o0[4 * rg + 1] * rs * g0[1]); w0.y = pk2(o0[4 * rg + 2] * rs * g0[2], o0[4 * rg + 3] * rs * g0[3]);
        w1.x = pk2(o1[4 * rg + 0] * rs * g1[0], o1[4 * rg + 1] * rs * g1[1]); w1.y = pk2(o1[4 * rg + 2] * rs * g1[2], o1[4 * rg + 3] * rs * g1[3]);
        *(u32x2*)(orow + d) = w0; *(u32x2*)(orow + 32 + d) = w1;
    }
}

__device__ __forceinline__ void hgrnA_unit(const Ctx& X, int b, int h, int n, bf16_t* qb, const float* gl, const bf16_t* ib, float* ointra, bf16_t* U, float* adec) {
    constexpr int QS = 0, KS = 17408, K2T = 34816, IT = 53248, SC = 71680, SEG = 80896;
    LAS bf16_t* Qs = (LAS bf16_t*)(X.lds + QS); LAS bf16_t* Ks = (LAS bf16_t*)(X.lds + KS); LAS bf16_t* K2t = (LAS bf16_t*)(X.lds + K2T);
    LAS bf16_t* It = (LAS bf16_t*)(X.lds + IT); LAS bf16_t* Sc = (LAS bf16_t*)(X.lds + SC); LAS float* segsum = (LAS float*)(X.lds + SEG);
    const int tid = X.tid, lane = X.lane, wave = X.wave, fr = lane & 15, fq = lane >> 4;
    const size_t row0 = (size_t)b * SEQ + n * 64; const int cid = (b * 8 + h) * 32 + n;
    const int d4 = (tid & 31) * 4, ts = tid >> 5;
    f32x4 g[4], bb[4]; u32x2 qraw[4];
#pragma unroll
    for (int i = 0; i < 4; ++i) { const size_t ro = (row0 + 4 * ts + i) * AWID + h * 128 + d4; g[i] = *(const f32x4*)(gl + ro); qraw[i] = *(const u32x2*)(qb + ro); }
    u32x4 iv[2];
#pragma unroll
    for (int k = 0; k < 2; ++k) { const int p = tid + NTHR * k, s_ = p & 63, ch = p >> 6; iv[k] = *(const u32x4*)(ib + (row0 + s_) * AWID + h * 128 + ch * 8); }
    f32x4 run = (f32x4){0.f, 0.f, 0.f, 0.f};
#pragma unroll
    for (int i = 0; i < 4; ++i) { run += g[i]; bb[i] = run; }
    *(LAS f32x4*)(segsum + ts * 128 + d4) = run;
#pragma unroll
    for (int k = 0; k < 2; ++k) {
        const int p = tid + NTHR * k, s_ = p & 63, ch = p >> 6; const u32x4 v = iv[k];
        LAS bf16_t* it_ = It + (ch * 8) * 72 + s_;
        it_[0 * 72] = (bf16_t)(v.x & 0xffffu); it_[1 * 72] = (bf16_t)(v.x >> 16); it_[2 * 72] = (bf16_t)(v.y & 0xffffu); it_[3 * 72] = (bf16_t)(v.y >> 16);
        it_[4 * 72] = (bf16_t)(v.z & 0xffffu); it_[5 * 72] = (bf16_t)(v.z >> 16); it_[6 * 72] = (bf16_t)(v.w & 0xffffu); it_[7 * 72] = (bf16_t)(v.w >> 16);
    }
    __syncthreads();
    f32x4 off = (f32x4){0.f, 0.f, 0.f, 0.f}, tot = off;
#pragma unroll
    for (int s_ = 0; s_ < 16; ++s_) { const f32x4 v = *(const LAS f32x4*)(segsum + s_ * 128 + d4); tot += v; if (s_ < ts) off += v; }
    f32x4 etot;
#pragma unroll
    for (int j = 0; j < 4; ++j) etot[j] = fast_exp(tot[j]);
    f32x4 k2[4];
#pragma unroll
    for (int i = 0; i < 4; ++i) {
        const int t = 4 * ts + i; const f32x4 bv = bb[i] + off; f32x4 qt, kt;
        const float q0 = bflo(qraw[i].x), q1 = bfhi(qraw[i].x), q2 = bflo(qraw[i].y), q3 = bfhi(qraw[i].y);
        qt[0] = q0 * fast_exp(bv[0]); qt[1] = q1 * fast_exp(bv[1]); qt[2] = q2 * fast_exp(bv[2]); qt[3] = q3 * fast_exp(bv[3]);
#pragma unroll
        for (int j = 0; j < 4; ++j) { const float kk = 1.f - fast_exp(g[i][j]); kt[j] = kk * fast_exp(-bv[j]); k2[i][j] = kt[j] * etot[j]; }
        u32x2 wq_, wk_; wq_.x = pk2(qt[0], qt[1]); wq_.y = pk2(qt[2], qt[3]); wk_.x = pk2(kt[0], kt[1]); wk_.y = pk2(kt[2], kt[3]);
        *(LAS u32x2*)(Qs + t * 136 + d4) = wq_; *(u32x2*)(qb + (row0 + t) * AWID + h * 128 + d4) = wq_;
        *(LAS u32x2*)(Ks + t * 136 + d4) = wk_;
    }
#pragma unroll
    for (int j = 0; j < 4; ++j) { u32x2 w; w.x = pk2(k2[0][j], k2[1][j]); w.y = pk2(k2[2][j], k2[3][j]); *(LAS u32x2*)(K2t + (d4 + j) * 72 + 4 * ts) = w; }
    if (ts == 0) *(f32x4*)(adec + (size_t)cid * 128 + d4) = etot;
    __syncthreads();
    {
        const int sb = wave >> 1;
#pragma unroll
        for (int k = 0; k < 2; ++k) {
            const int tb = (wave & 1) * 2 + k; f32x4 acc = (f32x4){0.f, 0.f, 0.f, 0.f};
            if (tb >= sb) {
                acc = mma16<128>(Ks + sb * 16 * 136, 136, Qs + tb * 16 * 136, 136, fr, fq, acc);
                const int t_ = 16 * tb + fr, s_ = 16 * sb + 4 * fq;
#pragma unroll
                for (int j = 0; j < 4; ++j) if (s_ + j > t_) acc[j] = 0.f;
            }
            u32x2 w; w.x = pk2(acc[0], acc[1]); w.y = pk2(acc[2], acc[3]);
            *(LAS u32x2*)(Sc + (16 * tb + fr) * 72 + 16 * sb + 4 * fq) = w;
        }
    }
    __syncthreads();
    {
        const int tb = wave & 3;
#pragma unroll
        for (int k = 0; k < 4; ++k) {
            const int eb = (wave >> 2) * 4 + k; f32x4 acc = (f32x4){0.f, 0.f, 0.f, 0.f};
            acc = mma16<64>(It + eb * 16 * 72, 72, Sc + tb * 16 * 72, 72, fr, fq, acc);
            *(f32x4*)(ointra + (row0 + 16 * tb + fr) * AWID + h * 128 + 16 * eb + 4 * fq) = acc;
        }
    }
    {
        bf16_t* Uc = U + (size_t)cid * 16384;
#pragma unroll
        for (int eb = 0; eb < 8; ++eb) {
            f32x4 acc = (f32x4){0.f, 0.f, 0.f, 0.f};
            acc = mma16<64>(K2t + wave * 16 * 72, 72, It + eb * 16 * 72, 72, fr, fq, acc);
            u32x2 w; w.x = pk2(acc[0], acc[1]); w.y = pk2(acc[2], acc[3]);
            *(u32x2*)(Uc + (16 * eb + fr) * 128 + 16 * wave + 4 * fq) = w;
        }
    }
    __syncthreads();
}

__device__ __forceinline__ void ph_scan(const Ctx& X, const bf16_t* U, const float* adec, bf16_t* Sp) {
    for (int item = blockIdx.x; item < 256; item += gridDim.x) {
        const int bh = item >> 3, sl = item & 7, e = sl * 16 + (X.tid >> 5), d4 = (X.tid & 31) * 4;
        f32x4 S = (f32x4){0.f, 0.f, 0.f, 0.f};
#pragma unroll 4
        for (int n = 0; n < 32; ++n) {
            const int cid = bh * 32 + n; const size_t off = (size_t)cid * 16384 + e * 128 + d4;
            u32x2 w; w.x = pk2(S[0], S[1]); w.y = pk2(S[2], S[3]);
            *(u32x2*)(Sp + off) = w;
            const u32x2 uu = *(const u32x2*)(U + off); const f32x4 a = *(const f32x4*)(adec + (size_t)cid * 128 + d4);
            S[0] = a[0] * S[0] + bflo(uu.x); S[1] = a[1] * S[1] + bfhi(uu.x); S[2] = a[2] * S[2] + bflo(uu.y); S[3] = a[3] * S[3] + bfhi(uu.y);
        }
    }
}

__device__ __forceinline__ void hgrnC_unit(const Ctx& X, int b, int h, int n, const bf16_t* qb, const bf16_t* Sp, const float* ointra, const bf16_t* gb, const float* gng, bf16_t* mix) {
    constexpr int SS = 0, QS = 34816, SSQ = 52224;
    LAS bf16_t* Ss = (LAS bf16_t*)(X.lds + SS); LAS bf16_t* Qs = (LAS bf16_t*)(X.lds + QS); LAS float* ssq = (LAS float*)(X.lds + SSQ);
    const int tid = X.tid, lane = X.lane, wave = X.wave, fr = lane & 15, fq = lane >> 4;
    const size_t row0 = (size_t)b * SEQ + n * 64; const int cid = (b * 8 + h) * 32 + n;
#pragma unroll
    for (int k = 0; k < 4; ++k) { const int p = tid + NTHR * k, e = p >> 4, ch = p & 15; *(LAS u32x4*)(Ss + e * 136 + ch * 8) = *(const u32x4*)(Sp + (size_t)cid * 16384 + e * 128 + ch * 8); }
#pragma unroll
    for (int k = 0; k < 2; ++k) { const int p = tid + NTHR * k, t = p >> 4, ch = p & 15; *(LAS u32x4*)(Qs + t * 136 + ch * 8) = *(const u32x4*)(qb + (row0 + t) * AWID + h * 128 + ch * 8); }
    __syncthreads();
    const int tb = wave & 3, eh = wave >> 2; const size_t row = row0 + 16 * tb + fr;
    f32x4 acc[4]; float ss = 0.f;
#pragma unroll
    for (int k = 0; k < 4; ++k) {
        const int eb = eh * 4 + k;
        acc[k] = *(const f32x4*)(ointra + row * AWID + h * 128 + 16 * eb + 4 * fq);
        acc[k] = mma16<128>(Ss + eb * 16 * 136, 136, Qs + tb * 16 * 136, 136, fr, fq, acc[k]);
        ss += (acc[k][0] * acc[k][0] + acc[k][1] * acc[k][1]) + (acc[k][2] * acc[k][2] + acc[k][3] * acc[k][3]);
    }
    ss += __shfl_xor(ss, 16); ss += __shfl_xor(ss, 32);
    if (fq == 0) ssq[eh * 64 + 16 * tb + fr] = ss;
    __syncthreads();
    const float tot = ssq[16 * tb + fr] + ssq[64 + 16 * tb + fr], rs = 1.f / sqrtf(tot * (1.f / 128.f) + LN_EPS);
#pragma unroll
    for (int k = 0; k < 4; ++k) {
        const int e0 = 16 * (eh * 4 + k) + 4 * fq;
        const f32x4 gg = *(const f32x4*)(gng + e0); const u32x2 sg = *(const u32x2*)(gb + row * AWID + h * 128 + e0);
        u32x2 w;
        w.x = pk2(acc[k][0] * rs * gg[0] * bflo(sg.x), acc[k][1] * rs * gg[1] * bfhi(sg.x));
        w.y = pk2(acc[k][2] * rs * gg[2] * bflo(sg.y), acc[k][3] * rs * gg[3] * bfhi(sg.y));
        *(u32x2*)(mix + row * DM + 1024 + h * 128 + e0) = w;
    }
    __syncthreads();
}

__device__ __forceinline__ void ph_rows1(const Ctx& X, const float* y1, const float* ln_g, const float* ln_b, const float* modf, float* x1, bf16_t* h2) {
    LAS float* tab = (LAS float*)X.lds;
    for (int rb = blockIdx.x; rb < 256; rb += gridDim.x) {
        const int batch = rb >> 6;
        for (int i = X.tid; i < 2048; i += NTHR) { tab[i] = ln_g[i]; tab[2048 + i] = ln_b[i]; tab[4096 + i] = 1.f + modf[(size_t)batch * NMOD + 4 * DM + i]; tab[6144 + i] = modf[(size_t)batch * NMOD + 3 * DM + i]; }
        __syncthreads();
        for (int r = X.wave; r < 32; r += 8) {
            const size_t row = (size_t)rb * 32 + r; const float* yr = y1 + row * DM + 4 * X.lane;
            f32x4 v[8];
#pragma unroll
            for (int j = 0; j < 8; ++j) v[j] = *(const f32x4*)(yr + 256 * j);
            ln_norm8(v);
            float* xr = x1 + row * DM + 4 * X.lane;
#pragma unroll
            for (int j = 0; j < 8; ++j) { const int c = 4 * X.lane + 256 * j; v[j] = v[j] * *(const LAS f32x4*)(tab + c) + *(const LAS f32x4*)(tab + 2048 + c); *(f32x4*)(xr + 256 * j) = v[j]; }
            ln_norm8(v);
            bf16_t* hr = h2 + row * DM + 4 * X.lane;
#pragma unroll
            for (int j = 0; j < 8; ++j) { const int c = 4 * X.lane + 256 * j; const f32x4 o = v[j] * *(const LAS f32x4*)(tab + 4096 + c) + *(const LAS f32x4*)(tab + 6144 + c);
                u32x2 w; w.x = pk2(o[0], o[1]); w.y = pk2(o[2], o[3]); *(u32x2*)(hr + 256 * j) = w; }
        }
        __syncthreads();
    }
}
__device__ __forceinline__ void ph_rows2(const Ctx& X, float* y2, const float* ln_g, const float* ln_b) {
    LAS float* tab = (LAS float*)X.lds;
    for (int i = X.tid; i < 2048; i += NTHR) { tab[i] = ln_g[i]; tab[2048 + i] = ln_b[i]; }
    __syncthreads();
    for (int row = blockIdx.x * 8 + X.wave; row < MROWS; row += gridDim.x * 8) {
        float* yr = y2 + (size_t)row * DM + 4 * X.lane;
        f32x4 v[8];
#pragma unroll
        for (int j = 0; j < 8; ++j) v[j] = *(const f32x4*)(yr + 256 * j);
        ln_norm8(v);
#pragma unroll
        for (int j = 0; j < 8; ++j) { const int c = 4 * X.lane + 256 * j; *(f32x4*)(yr + 256 * j) = v[j] * *(const LAS f32x4*)(tab + c) + *(const LAS f32x4*)(tab + 2048 + c); }
    }
    __syncthreads();
}

#define XB_TMO      128
#define XB_XCNT(j)  (256  + 64 * (j))
#define XB_XSUB(j)  (1280 + 64 * (j))
#define XB_XGEN(j)  (2304 + 64 * (j))
#define XB_TOP      3328
#define XB_TOPGEN   3392
#define XCD_BAR_WORDS 3456
#define XB_SPIN_CAP (1u << 18)

__device__ __forceinline__ unsigned xb_ld(unsigned* p)              { return __hip_atomic_load(p, __ATOMIC_RELAXED, __HIP_MEMORY_SCOPE_AGENT); }
__device__ __forceinline__ unsigned xb_add(unsigned* p, unsigned v) { return __hip_atomic_fetch_add(p, v, __ATOMIC_RELAXED, __HIP_MEMORY_SCOPE_AGENT); }
__device__ __forceinline__ unsigned xb_xcc_id() { return (unsigned)__builtin_amdgcn_s_getreg((3 << 11) | 20) & 0xFu; }
#define XB_SPIN(cond, bar) do { unsigned _sp = 0; while (cond) { __builtin_amdgcn_s_sleep(1); \
    if ((++_sp & 255u) == 0u) { if (xb_ld(&(bar)[XB_TMO])) break; if (_sp > XB_SPIN_CAP) { atomicAdd(&(bar)[XB_TMO], 1u); break; } } } } while (0)

struct XcdBarrier {
    unsigned* bar; unsigned x;
    volatile LAS unsigned* st;
};

__device__ __forceinline__ XcdBarrier xcd_barrier_post(unsigned* bar, volatile LAS unsigned* st) {
    XcdBarrier b; b.bar = bar; b.x = xb_xcc_id(); b.st = st;
    if (threadIdx.x == 0) (void)xb_add(&bar[XB_XCNT(b.x)], 1u);
    return b;
}
__device__ __forceinline__ void xcd_barrier_complete(unsigned* bar, unsigned x, unsigned& nloc, unsigned& nx) {
    const unsigned G = gridDim.x * gridDim.y * gridDim.z;
    unsigned sum, cnt, mine, sp = 0u;
    for (;;) {
        sum = 0u; cnt = 0u; mine = 0u;
#pragma unroll
        for (unsigned j = 0; j < 16; ++j) { const unsigned c = xb_ld(&bar[XB_XCNT(j)]); sum += c; cnt += (c > 0u) ? 1u : 0u; mine = (j == x) ? c : mine; }
        if (sum == G) break;
        __builtin_amdgcn_s_sleep(1);
        if ((++sp & 255u) == 0u) { if (xb_ld(&bar[XB_TMO])) break; if (sp > XB_SPIN_CAP) { atomicAdd(&bar[XB_TMO], 1u); break; } }
    }
    nloc = mine > 0u ? mine : 1u; nx = cnt > 0u ? cnt : 1u;
}

__device__ __forceinline__ void xcd_barrier(const XcdBarrier& b) {
    asm volatile("s_waitcnt vmcnt(0)" ::: "memory");
    __syncthreads();
    if (threadIdx.x == 0) {
        unsigned* bar = b.bar;
        __builtin_amdgcn_s_waitcnt(0);
        unsigned nloc = b.st[0], nx = b.st[1];
        if (nloc == 0u) { xcd_barrier_complete(bar, b.x, nloc, nx); b.st[0] = nloc; b.st[1] = nx; }
        const unsigned old = xb_add(&bar[XB_XSUB(b.x)], 1u);
        const unsigned gen = old / nloc;
        if (old + 1u == (gen + 1u) * nloc) {
            __builtin_amdgcn_fence(__ATOMIC_RELEASE, "agent");
            asm volatile("s_waitcnt vmcnt(0)" ::: "memory");
            const unsigned og = xb_add(&bar[XB_TOP], 1u);
            const unsigned tg = og / nx;
            if (og + 1u == (tg + 1u) * nx) xb_add(&bar[XB_TOPGEN], 1u);
            else XB_SPIN(xb_ld(&bar[XB_TOPGEN]) == tg, bar);
            __builtin_amdgcn_fence(__ATOMIC_ACQUIRE, "agent");
            xb_add(&bar[XB_XGEN(b.x)], 1u);
            asm volatile("s_waitcnt vmcnt(0)" ::: "memory");
        } else {
            XB_SPIN(xb_ld(&bar[XB_XGEN(b.x)]) == gen, bar);
            __builtin_amdgcn_fence(__ATOMIC_ACQUIRE, "agent");
            asm volatile("s_waitcnt vmcnt(0)" ::: "memory");
        }
    }
    __syncthreads();
}

constexpr int N_PHASES = 11;
constexpr int BAR_LDS_OFF = 131072 + 64;
constexpr size_t CTL_ZERO_BYTES = 16384;
#ifndef MK_PER_PHASE
#define MK_PER_PHASE 0
#endif
#ifndef PROBE_PHASE
#define PROBE_PHASE -1
#endif
#ifndef PROBE_MASK
#define PROBE_MASK 0
#endif
#define PROBE_T0(k) do { if ((PROBE_MASK >> (k)) & 1) pt0_ = __builtin_amdgcn_s_memrealtime(); } while (0)
#define PROBE_DLY(k) do { if ((PROBE_MASK >> (k)) & 1) { const unsigned long long t1_ = __builtin_amdgcn_s_memrealtime(), dt_ = t1_ - pt0_; while (__builtin_amdgcn_s_memrealtime() - t1_ < dt_) __builtin_amdgcn_s_sleep(8); } } while (0)
#define REP(k) for (int rep_ = 0; rep_ < ((PROBE_PHASE == (k)) ? 2 : 1); ++rep_)
__device__ __forceinline__ bool ph_in(int lo, int hi, int k) { asm volatile("" : "+s"(lo), "+s"(hi)); return lo <= k && k < hi; }
__global__ void __launch_bounds__(NTHR, 2) mk_fwd(Args a) {
    extern __shared__ __attribute__((aligned(16))) unsigned char lds_raw[];
    LAS unsigned char* const ldsb = (LAS unsigned char*)lds_raw;
#define X mk_ctx(ldsb)
    unsigned char* ws = a.ws;
    const float *x = a.in[0], *c = a.in[1], *w_ada = a.in[2], *b_ada = a.in[3], *w_in = a.in[4], *rel_bias = a.in[5], *attn_g = a.in[6], *lb_logits = a.in[7], *gnorm_g = a.in[8],
                *w_o = a.in[9], *ln1_g = a.in[10], *ln1_b = a.in[11], *w_fi = a.in[12], *w_fo = a.in[13], *ln2_g = a.in[14], *ln2_b = a.in[15];
    float* modp = (float*)(ws + WS_MODP); float* modf = (float*)(ws + WS_MODF);
    bf16_t *win_t = (bf16_t*)(ws + WS_WIN), *wo_t = (bf16_t*)(ws + WS_WO), *wfi_t = (bf16_t*)(ws + WS_WFI), *wfo_t = (bf16_t*)(ws + WS_WFO);
    float* adec = (float*)(ws + WS_ADEC);
    bf16_t* hbuf = (bf16_t*)(ws + WS_H); float* ointra = (float*)(ws + WS_H);
    bf16_t *qa = (bf16_t*)(ws + WS_QA), *ka = (bf16_t*)(ws + WS_KA), *va = (bf16_t*)(ws + WS_VA), *qb = (bf16_t*)(ws + WS_QB), *ib = (bf16_t*)(ws + WS_IB), *gb = (bf16_t*)(ws + WS_GB);
    float* gl = (float*)(ws + WS_GL);
    bf16_t *mix = (bf16_t*)(ws + WS_MIX), *U = (bf16_t*)(ws + WS_U), *Sp = (bf16_t*)(ws + WS_SP), *uff = (bf16_t*)(ws + WS_UFF);
    float *y1 = (float*)(ws + WS_Y1), *x1 = (float*)(ws + WS_X1);
#if MK_PER_PHASE
#define IN(k) ph_in(a.ph_lo, a.ph_hi, (k))
#define SEAM(k) do { } while (0)
#else
#define IN(k) true
#define SEAM(k) do { xcd_barrier(bar); PROBE_DLY(k); PROBE_T0((k) + 1); } while (0)
    unsigned long long pt0_ = 0; PROBE_T0(0);
    if (X.tid < 2) ((volatile LAS unsigned*)(X.lds + BAR_LDS_OFF))[X.tid] = 0u;
    __syncthreads();
    XcdBarrier bar = xcd_barrier_post((unsigned*)ws, (volatile LAS unsigned*)(X.lds + BAR_LDS_OFF));
    if (a.ph_lo == 0x7fffffff) cg::this_grid().sync();
#endif

#if PROBE_PHASE == 99
    for (int pass_ = 0; pass_ < 2; ++pass_) {
#endif
    if (IN(0)) { ph_mod_partial(X, c, w_ada, modp); }
#if PROBE_PHASE == 0
    ph_mod_partial(X, c, w_ada, modp);
#endif
    SEAM(0);
    if (IN(1)) { ph_h1(X, x, modp, b_ada, hbuf); ph_modf(X, modp, b_ada, modf); ph_weights(X, w_in, w_o, w_fi, w_fo, win_t, wo_t, wfi_t, wfo_t); }
#if PROBE_PHASE == 1
    __syncthreads(); ph_h1(X, x, modp, b_ada, hbuf);
#endif
#if PROBE_PHASE == 11
    __syncthreads(); ph_weights(X, w_in, w_o, w_fi, w_fo, win_t, wo_t, wfi_t, wfo_t);
#endif
    SEAM(1);
    if (IN(2)) {
        pg8::Gemm g{hbuf, win_t, MROWS, NIN, DM}; pg8::StaticOrder S; S.init(MROWS, NIN, (int)gridDim.x, (int)blockIdx.x);
        EpiInProj E{qa, ka, va, qb, ib, gb, gl, lb_logits};
        pg8::gemm_phase<EpiInProj, pg8::StaticOrder, true, true>(X.lds, g, S, E);
    }
#if PROBE_PHASE == 2
    {
        pg8::Gemm g{hbuf, win_t, MROWS, NIN, DM}; pg8::StaticOrder S; S.init(MROWS, NIN, (int)gridDim.x, (int)blockIdx.x);
        EpiInProj E{qa, ka, va, qb, ib, gb, gl, lb_logits};
        pg8::gemm_phase<EpiInProj, pg8::StaticOrder, true, true>(X.lds, g, S, E);
    }
#endif
    SEAM(2);
    if (IN(3)) {
        __syncthreads();
        REP(30) for (int u = blockIdx.x; u < 512; u += gridDim.x) { const int c4 = u & 7, bh = u >> 3; attn_unit(X, bh >> 4, bh & 15, c4, qa, ka, va, rel_bias, attn_g, mix); }
        for (int u = blockIdx.x; u < 1024; u += gridDim.x) { const int n = u & 31, bh = u >> 5; hgrnA_unit(X, bh >> 3, bh & 7, n, qb, gl, ib, ointra, U, adec); }
    } SEAM(3);
    if (IN(4)) { ph_scan(X, U, adec, Sp); }
#if PROBE_PHASE == 4
    ph_scan(X, U, adec, Sp);
#endif
    SEAM(4);
    if (IN(5)) REP(5) {
        for (int u = blockIdx.x; u < 1024; u += gridDim.x) { const int n = u & 31, bh = u >> 5; hgrnC_unit(X, bh >> 3, bh & 7, n, qb, Sp, ointra, gb, gnorm_g, mix); }
    } SEAM(5);
    if (IN(6)) {
        pg8::Gemm g{mix, wo_t, MROWS, DM, DM}; pg8::StaticOrder S; S.init(MROWS, DM, (int)gridDim.x, (int)blockIdx.x);
        EpiResid E{x, modf + 2 * DM, y1};
        pg8::gemm_phase<EpiResid, pg8::StaticOrder, true, true>(X.lds, g, S, E);
    }
#if PROBE_PHASE == 6
    {
        pg8::Gemm g{mix, wo_t, MROWS, DM, DM}; pg8::StaticOrder S; S.init(MROWS, DM, (int)gridDim.x, (int)blockIdx.x);
        EpiResid E{x, modf + 2 * DM, y1};
        pg8::gemm_phase<EpiResid, pg8::StaticOrder, true, true>(X.lds, g, S, E);
    }
#endif
    SEAM(6);
    if (IN(7)) { __syncthreads(); ph_rows1(X, y1, ln1_g, ln1_b, modf, x1, hbuf); }
#if PROBE_PHASE == 7
    ph_rows1(X, y1, ln1_g, ln1_b, modf, x1, hbuf);
#endif
    SEAM(7);
    if (IN(8)) {
        pg8::Gemm g{hbuf, wfi_t, MROWS, NFF2, DM}; pg8::StaticOrder S; S.init(MROWS, NFF2, (int)gridDim.x, (int)blockIdx.x);
        EpiSwiglu E{uff};
        pg8::gemm_phase<EpiSwiglu, pg8::StaticOrder, true, true>(X.lds, g, S, E);
    }
#if PROBE_PHASE == 8
    {
        pg8::Gemm g{hbuf, wfi_t, MROWS, NFF2, DM}; pg8::StaticOrder S; S.init(MROWS, NFF2, (int)gridDim.x, (int)blockIdx.x);
        EpiSwiglu E{uff};
        pg8::gemm_phase<EpiSwiglu, pg8::StaticOrder, true, true>(X.lds, g, S, E);
    }
#endif
    SEAM(8);
    if (IN(9)) {
        pg8::Gemm g{uff, wfo_t, MROWS, DM, DFF}; pg8::StaticOrder S; S.init(MROWS, DM, (int)gridDim.x, (int)blockIdx.x);
        EpiResid E{x1, modf + 5 * DM, a.out};
        pg8::gemm_phase<EpiResid, pg8::StaticOrder, true, true>(X.lds, g, S, E);
    }
#if PROBE_PHASE == 9
    {
        pg8::Gemm g{uff, wfo_t, MROWS, DM, DFF}; pg8::StaticOrder S; S.init(MROWS, DM, (int)gridDim.x, (int)blockIdx.x);
        EpiResid E{x1, modf + 5 * DM, a.out};
        pg8::gemm_phase<EpiResid, pg8::StaticOrder, true, true>(X.lds, g, S, E);
    }
#endif
    SEAM(9);
    if (IN(10)) { __syncthreads(); ph_rows2(X, a.out, ln2_g, ln2_b); PROBE_DLY(10); }
#if PROBE_PHASE == 99
    if (pass_ == 0) xcd_barrier(bar);
    }
#endif
#undef IN
#undef SEAM
#undef X
}

#ifndef MK_PER_PHASE
#define MK_PER_PHASE 0
#endif
extern "C" void kernel_launch(void* const* d_in, const int* in_sizes, int n_in, void* d_out, int out_size, void* d_ws, size_t ws_size, hipStream_t stream) {
    static int grid = 0;
    if (grid == 0) {
        if (n_in != 16 || in_sizes[0] != MROWS * DM || out_size != MROWS * DM || ws_size < WS_END) {
            fprintf(stderr, "kernel_launch: unexpected shapes (n_in %d, in0 %d, out %d, ws %zu; need ws >= %zu); nothing launched\n", n_in, n_in > 0 ? in_sizes[0] : -1, out_size, ws_size, (size_t)WS_END); grid = -1; return; }
        int dev = 0, cus = 0, per_cu = 0;
        hipGetDevice(&dev); hipDeviceGetAttribute(&cus, hipDeviceAttributeMultiprocessorCount, dev);
        if (hipFuncSetAttribute((const void*)mk_fwd, hipFuncAttributeMaxDynamicSharedMemorySize, LDS_BYTES) != hipSuccess) { fprintf(stderr, "kernel_launch: hipFuncSetAttribute failed\n"); grid = -1; return; }
        if (hipOccupancyMaxActiveBlocksPerMultiprocessor(&per_cu, (const void*)mk_fwd, NTHR, LDS_BYTES) != hipSuccess || per_cu < 1) { fprintf(stderr, "kernel_launch: occupancy query says %d blocks per CU\n", per_cu); (void)hipGetLastError(); grid = -1; return; }
        grid = cus;
    }
    if (grid < 0) return;
    Args a{};
    for (int i = 0; i < 16; ++i) a.in[i] = (const float*)d_in[i];
    a.out = (float*)d_out; a.ws = (unsigned char*)d_ws;
#if MK_PER_PHASE
    for (int p = 0; p < N_PHASES; ++p) {
        a.ph_lo = p; a.ph_hi = p + 1; void* args[] = {&a};
        hipError_t e = hipLaunchCooperativeKernel((const void*)mk_fwd, dim3(grid), dim3(NTHR), args, LDS_BYTES, stream);
        if (e != hipSuccess) { fprintf(stderr, "kernel_launch: launch %d failed: %s\n", p, hipGetErrorString(e)); break; }
    }
#else
    if (hipMemsetAsync(d_ws, 0, CTL_ZERO_BYTES, stream) != hipSuccess) { fprintf(stderr, "kernel_launch: memset of the barrier words failed\n"); return; }
    a.ph_lo = 0; a.ph_hi = N_PHASES; void* args[] = {&a};
    hipError_t e = hipLaunchCooperativeKernel((const void*)mk_fwd, dim3(grid), dim3(NTHR), args, LDS_BYTES, stream);
    if (e != hipSuccess) fprintf(stderr, "kernel_launch: cooperative launch failed: %s (grid %d)\n", hipGetErrorString(e), grid);
#if PROBE_PHASE == 98
    (void)hipMemsetAsync(d_ws, 0, CTL_ZERO_BYTES, stream);
    (void)hipLaunchCooperativeKernel((const void*)mk_fwd, dim3(grid), dim3(NTHR), args, LDS_BYTES, stream);
#endif
#endif
}
```

```cpp
#include <hip/hip_runtime.h>
#include <hip/hip_cooperative_groups.h>
#include <cstdio>
#include <cstdint>
namespace cg = cooperative_groups;
namespace pg8 {
#define PG8_LAS __attribute__((address_space(3)))
typedef unsigned short bf16_t;
typedef short bf16x8 __attribute__((ext_vector_type(8)));
typedef float f32x4 __attribute__((ext_vector_type(4)));
typedef unsigned u32x4 __attribute__((ext_vector_type(4)));
constexpr int BM = 256, BK = 64, HALF = 128, HTB = HALF * BK * 2  , STAGE_BYTES = 8 * HTB, NXCD = 8, WGM = 8;

__host__ __device__ __forceinline__ int lds_byte(int r, int c) { const int st = (r >> 4) * 2 + (c >> 5), rr = r & 15, cc = c & 31, ob = rr * 64 + cc * 2; return st * 1024 + (ob ^ (((ob >> 9) & 1) << 5)); }
__host__ __device__ __forceinline__ void stage_rc(int b, int& R, int& C) { const int st = b / 1024, sb = b % 1024, swz = sb ^ (((sb >> 9) & 1) << 5); R = (st >> 1) * 16 + swz / 64; C = (st & 1) * 32 + (swz % 64) / 2; }
__host__ __device__ __forceinline__ int perm32(int rho) { const int n = rho >> 4, i = rho & 15; return 8 * (i >> 2) + 4 * n + (i & 3); }

struct Unit { int pm, pn; };
struct Gemm { const bf16_t* A; const bf16_t* Bt; int M, N, K; };

struct StaticOrder {
    int nM, nN, nwg, G, c;
    __host__ __device__ void init(int M, int N, int G_, int c_) { nM = M / BM; nN = N / BM; nwg = nM * nN; G = G_; c = c_; }
    __host__ __device__ bool next(int i, Unit& u) const {
        const long L = (long)i * G + c; if (L >= nwg) return false;
        int wgid = (int)L; { const int q = nwg / NXCD, r = nwg % NXCD, xcd = wgid % NXCD, off = wgid / NXCD; wgid = (xcd < r ? xcd * (q + 1) : r * (q + 1) + (xcd - r) * q) + off; }
        const int nig = WGM * nN, gid = wgid / nig, fm = gid * WGM, gsz = (nM - fm) < WGM ? (nM - fm) : WGM;
        u.pm = fm + ((wgid % nig) % gsz); u.pn = (wgid % nig) / gsz; return true;
    }
    __device__ __forceinline__ void a_ready(const Unit&) const {}
    __device__ __forceinline__ void done(const Unit&) const {}
};

template <class Epi, class Sched, bool ALIGN_EPI = false, bool SP2 = false>
__device__ __forceinline__ void gemm_phase(PG8_LAS unsigned char* lds, const Gemm g, const Sched& S, const Epi& E) {
    const int tid = threadIdx.x, wid = __builtin_amdgcn_readfirstlane(tid >> 6), lane = tid & 63, wr = wid >> 2, wc = wid & 3, fr = lane & 15, fq = lane >> 4;
    const int K = g.K, nt = K / BK;
    unsigned voffA[2], voffB[2];
#pragma unroll
    for (int i = 0; i < 2; ++i) { int R, C; stage_rc(tid * 16 + i * 8192, R, C); const int Rb = Epi::PERM ? ((R & ~31) + perm32(R & 31)) : R;
        voffA[i] = (unsigned)(R * K + C) * 2u; voffB[i] = (unsigned)(Rb * K + C) * 2u; }
    const size_t kstep = (size_t)(BK * 2);
    const size_t hstep = (size_t)HALF * K * 2;
    const size_t tstep = 2 * hstep;
    const unsigned ldsw = (unsigned)wid * 1024u;
    const int aoff = lds_byte(wr * 64 + fr, fq * 8), boff = lds_byte(wc * 32 + fr, fq * 8);
#define PG8_SA(b, h) (((b) * 2 + (h)) * HTB)
#define PG8_SB(b, h) ((4 + (b) * 2 + (h)) * HTB)
#define PG8_STAGE(bufoff, gbase, voff) do { _Pragma("unroll") for (int _i = 0; _i < 2; ++_i) \
        __builtin_amdgcn_global_load_lds((const unsigned*)((const char*)(gbase) + (voff)[_i]), (PG8_LAS unsigned*)(lds + (bufoff) + ldsw + _i * 8192), 16, 0, 0); } while (0)
#define PG8_LDA(dst, b, h) do { _Pragma("unroll") for (int m = 0; m < 4; ++m) _Pragma("unroll") for (int k = 0; k < 2; ++k) dst[m][k] = *(const PG8_LAS bf16x8*)(lds + PG8_SA(b, h) + aoff + m * 2048 + k * 1024); } while (0)
#define PG8_LDB(dst, b, h) do { _Pragma("unroll") for (int n = 0; n < 2; ++n) _Pragma("unroll") for (int k = 0; k < 2; ++k) dst[n][k] = *(const PG8_LAS bf16x8*)(lds + PG8_SB(b, h) + boff + n * 2048 + k * 1024); } while (0)
#define PG8_MMA(ai, bj, At, Bt) do { __builtin_amdgcn_s_setprio(1); _Pragma("unroll") for (int m = 0; m < 4; ++m) _Pragma("unroll") for (int n = 0; n < 2; ++n) _Pragma("unroll") for (int k = 0; k < 2; ++k) \
        acc[ai][bj][m][n] = __builtin_amdgcn_mfma_f32_16x16x32_bf16(Bt[n][k], At[m][k], acc[ai][bj][m][n], 0, 0, 0); __builtin_amdgcn_s_setprio(0); } while (0)
#define PG8_WAIT_V(n) asm volatile("s_waitcnt vmcnt(" #n ")" ::: "memory")
#define PG8_WAIT_L(n) asm volatile("s_waitcnt lgkmcnt(" #n ")" ::: "memory")
#define PG8_BAR __builtin_amdgcn_s_barrier()
#define PG8_SCHED __builtin_amdgcn_sched_barrier(0)
    Unit cur, nxt; int ui = 0;
    if (!S.next(0, cur)) return;
    f32x4 acc[2][2][4][2];
#pragma unroll
    for (int a = 0; a < 2; ++a)
#pragma unroll
        for (int b = 0; b < 2; ++b)
#pragma unroll
            for (int m = 0; m < 4; ++m)
#pragma unroll
                for (int n = 0; n < 2; ++n) acc[a][b][m][n] = (f32x4){0.f, 0.f, 0.f, 0.f};
    bf16x8 At[4][2], B0[2][2], B1[2][2];
    const char* cA = (const char*)g.A + (size_t)cur.pm * tstep; const char* cB = (const char*)g.Bt + (size_t)cur.pn * tstep;
    S.a_ready(cur);
    if constexpr (SP2) {
        PG8_STAGE(PG8_SB(0, 0), cB, voffB); PG8_STAGE(PG8_SB(0, 1), cB + hstep, voffB); PG8_STAGE(PG8_SA(0, 0), cA, voffA); PG8_STAGE(PG8_SA(0, 1), cA + hstep, voffA);
        if (wr == 1) PG8_BAR;
        PG8_WAIT_V(2); PG8_BAR;
        PG8_STAGE(PG8_SB(1, 0), cB + kstep, voffB); PG8_STAGE(PG8_SA(1, 0), cA + kstep, voffA); PG8_STAGE(PG8_SB(1, 1), cB + hstep + kstep, voffB);
        PG8_WAIT_V(6); PG8_BAR;
    } else {
        PG8_STAGE(PG8_SB(0, 0), cB, voffB); PG8_STAGE(PG8_SA(0, 0), cA, voffA); PG8_STAGE(PG8_SB(0, 1), cB + hstep, voffB); PG8_STAGE(PG8_SA(0, 1), cA + hstep, voffA);
        if (wr == 1) PG8_BAR;
        PG8_WAIT_V(4); PG8_BAR;
        PG8_STAGE(PG8_SB(1, 0), cB + kstep, voffB); PG8_STAGE(PG8_SA(1, 0), cA + kstep, voffA); PG8_STAGE(PG8_SB(1, 1), cB + hstep + kstep, voffB);
        PG8_WAIT_V(6); PG8_BAR;
    }
    for (;;) {
        const bool has_next = S.next(ui + 1, nxt);
        const char* nA = has_next ? (const char*)g.A + (size_t)nxt.pm * tstep : cA; const char* nB = has_next ? (const char*)g.Bt + (size_t)nxt.pn * tstep : cB;
        for (int t = 0; t < nt; t += 2) {
            const bool last = (t == nt - 2);
            const char* a1 = cA + (size_t)(t + 1) * kstep;
            const char* a2 = last ? nA : cA + (size_t)(t + 2) * kstep; const char* b2 = last ? nB : cB + (size_t)(t + 2) * kstep;
            const char* a3 = a2 + kstep; const char* b3 = b2 + kstep;
            if (last && has_next) S.a_ready(nxt);
            if constexpr (SP2) {
            PG8_LDB(B0, 0, 0); PG8_LDB(B1, 0, 1); PG8_SCHED; PG8_LDA(At, 0, 0); PG8_STAGE(PG8_SA(1, 1), a1 + hstep, voffA);
            PG8_WAIT_V(8); PG8_WAIT_L(0); PG8_BAR; PG8_MMA(0, 0, At, B0); PG8_MMA(0, 1, At, B1); PG8_BAR; PG8_SCHED;
            PG8_LDA(At, 0, 1); PG8_STAGE(PG8_SB(0, 0), b2, voffB); PG8_STAGE(PG8_SB(0, 1), b2 + hstep, voffB); PG8_STAGE(PG8_SA(0, 0), a2, voffA);
            PG8_WAIT_V(8); PG8_WAIT_L(0); PG8_BAR; PG8_MMA(1, 0, At, B0); PG8_MMA(1, 1, At, B1); PG8_BAR; PG8_SCHED;
            PG8_LDB(B0, 1, 0); PG8_LDB(B1, 1, 1); PG8_SCHED; PG8_LDA(At, 1, 0); PG8_STAGE(PG8_SA(0, 1), a2 + hstep, voffA);
            PG8_WAIT_V(8); PG8_WAIT_L(0); PG8_BAR; PG8_MMA(0, 0, At, B0); PG8_MMA(0, 1, At, B1); PG8_BAR; PG8_SCHED;
            PG8_LDA(At, 1, 1); PG8_STAGE(PG8_SB(1, 0), b3, voffB); PG8_STAGE(PG8_SB(1, 1), b3 + hstep, voffB); PG8_STAGE(PG8_SA(1, 0), a3, voffA);
            PG8_WAIT_V(8); PG8_WAIT_L(0); PG8_BAR; PG8_MMA(1, 0, At, B0); PG8_MMA(1, 1, At, B1); PG8_BAR; PG8_SCHED;
            } else {
            PG8_LDB(B0, 0, 0); PG8_SCHED; PG8_LDA(At, 0, 0); PG8_STAGE(PG8_SA(1, 1), a1 + hstep, voffA);
            PG8_WAIT_L(8); PG8_BAR; PG8_WAIT_L(0); PG8_MMA(0, 0, At, B0); PG8_BAR; PG8_SCHED;
            PG8_LDB(B1, 0, 1); PG8_STAGE(PG8_SB(0, 0), b2, voffB);
            PG8_BAR; PG8_WAIT_L(0); PG8_MMA(0, 1, At, B1); PG8_BAR;
            PG8_LDA(At, 0, 1); PG8_STAGE(PG8_SA(0, 0), a2, voffA);
            PG8_BAR; PG8_WAIT_L(0); PG8_MMA(1, 0, At, B0); PG8_BAR; PG8_SCHED;
            PG8_STAGE(PG8_SB(0, 1), b2 + hstep, voffB);
            PG8_WAIT_V(6); PG8_BAR; PG8_MMA(1, 1, At, B1); PG8_BAR;
            PG8_LDB(B0, 1, 0); PG8_SCHED; PG8_LDA(At, 1, 0); PG8_STAGE(PG8_SA(0, 1), a2 + hstep, voffA);
            PG8_WAIT_L(8); PG8_BAR; PG8_WAIT_L(0); PG8_MMA(0, 0, At, B0); PG8_BAR; PG8_SCHED;
            PG8_LDB(B1, 1, 1); PG8_STAGE(PG8_SB(1, 0), b3, voffB);
            PG8_BAR; PG8_WAIT_L(0); PG8_MMA(0, 1, At, B1); PG8_BAR;
            PG8_LDA(At, 1, 1); PG8_STAGE(PG8_SA(1, 0), a3, voffA);
            PG8_BAR; PG8_WAIT_L(0); PG8_MMA(1, 0, At, B0); PG8_BAR; PG8_SCHED;
            PG8_STAGE(PG8_SB(1, 1), b3 + hstep, voffB);
            PG8_WAIT_V(6); PG8_BAR; PG8_MMA(1, 1, At, B1); PG8_BAR;
            }
        }
        if constexpr (ALIGN_EPI) { if (wr == 0) PG8_BAR; }
        if constexpr (!Epi::AFTER_DRAIN) { E(acc, cur, wr, wc, fr, fq); S.done(cur); }
        if (!has_next) break;
#pragma unroll
        for (int a = 0; a < 2; ++a)
#pragma unroll
            for (int b = 0; b < 2; ++b)
#pragma unroll
                for (int m = 0; m < 4; ++m)
#pragma unroll
                    for (int n = 0; n < 2; ++n) acc[a][b][m][n] = (f32x4){0.f, 0.f, 0.f, 0.f};
        cur = nxt; cA = nA; cB = nB; ++ui;
        if constexpr (ALIGN_EPI) { if (wr == 1) PG8_BAR; }
    }
    PG8_WAIT_V(0);
    if constexpr (!ALIGN_EPI) { if (wr == 0) PG8_BAR; }
    PG8_BAR;
    if constexpr (Epi::AFTER_DRAIN) { E.fused(acc, cur, wr, wc, fr, fq, lds, wid, lane); S.done(cur); }
#undef PG8_SA
#undef PG8_SB
#undef PG8_STAGE
#undef PG8_LDA
#undef PG8_LDB
#undef PG8_MMA
#undef PG8_WAIT_V
#undef PG8_WAIT_L
#undef PG8_BAR
#undef PG8_SCHED
}
}

constexpr int NB = 4, SEQ = 2048, DM = 2048, MROWS = NB * SEQ;
constexpr int NIN = 7168, DFF = 5632, NFF2 = 2 * DFF, NMOD = 6 * DM;
constexpr int AWID = 1024;
constexpr float LN_EPS = 1e-5f;
constexpr float ALPHA = 1.189207115002721f;
constexpr float LOG2E = 1.4426950408889634f;
constexpr float QSCALE = 0.125f * LOG2E;

constexpr size_t MiB = 1u << 20;
constexpr size_t WS_MODP = 364 * MiB;
constexpr size_t WS_MODF = 2 * MiB + 1572864;
constexpr size_t WS_WIN = 4 * MiB, WS_WO = 32 * MiB, WS_WFI = 40 * MiB, WS_WFO = 84 * MiB;
constexpr size_t WS_ADEC = 106 * MiB;
constexpr size_t WS_H = 108 * MiB;
constexpr size_t WS_QA = 140 * MiB, WS_KA = 156 * MiB, WS_VA = 172 * MiB, WS_QB = 188 * MiB, WS_IB = 204 * MiB, WS_GB = 220 * MiB;
constexpr size_t WS_GL = 236 * MiB;
constexpr size_t WS_MIX = 268 * MiB;
constexpr size_t WS_U = 300 * MiB, WS_SP = 332 * MiB;
constexpr size_t WS_Y1 = 140 * MiB, WS_X1 = 204 * MiB;
constexpr size_t WS_UFF = 268 * MiB;
constexpr size_t WS_END = 368 * MiB;

constexpr int LDS_BYTES = 147456;
constexpr int NTHR = 512;

#define LAS __attribute__((address_space(3)))
typedef unsigned short bf16_t;
typedef short bf16x8 __attribute__((ext_vector_type(8)));
typedef short s16x4 __attribute__((ext_vector_type(4)));
typedef float f32x4 __attribute__((ext_vector_type(4)));
typedef float f32x2 __attribute__((ext_vector_type(2)));
typedef float f32x16 __attribute__((ext_vector_type(16)));
typedef unsigned u32x4 __attribute__((ext_vector_type(4)));
typedef unsigned u32x2 __attribute__((ext_vector_type(2)));
typedef __bf16 bf16x2_t __attribute__((ext_vector_type(2)));

__device__ __forceinline__ unsigned pk2(float lo, float hi) { f32x2 v = {lo, hi}; bf16x2_t b = __builtin_convertvector(v, bf16x2_t); return __builtin_bit_cast(unsigned, b); }
__device__ __forceinline__ bf16_t f2bf(float x) { return (bf16_t)(pk2(x, 0.f) & 0xffffu); }
__device__ __forceinline__ float bf2f(unsigned v) { return __uint_as_float(v << 16); }
__device__ __forceinline__ float bflo(unsigned w) { return __uint_as_float(w << 16); }
__device__ __forceinline__ float bfhi(unsigned w) { return __uint_as_float(w & 0xffff0000u); }
__device__ __forceinline__ float fast_exp(float x) { return __builtin_amdgcn_exp2f(x * LOG2E); }
__device__ __forceinline__ float silu_f(float x) { return x * __builtin_amdgcn_rcpf(1.f + __builtin_amdgcn_exp2f(-x * LOG2E)); }
__device__ __forceinline__ float wave_sum(float v) {
#pragma unroll
    for (int o = 1; o < 64; o <<= 1) v += __shfl_xor(v, o);
    return v;
}

struct EpiInProj {
    static constexpr bool PERM = true, AFTER_DRAIN = false;
    bf16_t *qa, *ka, *va, *qb, *ib, *gb; float* gl; const float* lbl;
    __device__ __forceinline__ void operator()(const f32x4 (&acc)[2][2][4][2], const pg8::Unit& u, int wr, int wc, int fr, int fq) const {
        const int seg = u.pn >> 2; const int colt = (u.pn & 3) * 256 + wc * 32 + 8 * fq; const int row0 = u.pm * 256 + wr * 64 + fr;
        if (seg == 4) {
#pragma unroll
            for (int bj = 0; bj < 2; ++bj) {
                const int c = colt + bj * 128; float lb[8];
#pragma unroll
                for (int i = 0; i < 8; ++i) { const float l0 = lbl[c + i], l1 = lbl[1024 + c + i]; lb[i] = 1.f / (1.f + __expf(l1 - l0)); }
#pragma unroll
                for (int ai = 0; ai < 2; ++ai)
#pragma unroll
                    for (int m = 0; m < 4; ++m) {
                        float* rp = gl + (size_t)(row0 + ai * 128 + m * 16) * AWID + c; f32x4 o0, o1;
#pragma unroll
                        for (int i = 0; i < 4; ++i) {
                            const float s0 = 1.f / (1.f + __expf(-acc[ai][bj][m][0][i])), s1 = 1.f / (1.f + __expf(-acc[ai][bj][m][1][i]));
                            o0[i] = __logf(lb[i] + (1.f - lb[i]) * s0); o1[i] = __logf(lb[4 + i] + (1.f - lb[4 + i]) * s1);
                        }
                        *(f32x4*)rp = o0; *(f32x4*)(rp + 4) = o1;
                    }
            }
        } else {
            bf16_t* base = seg == 0 ? qa : seg == 1 ? ka : seg == 2 ? va : seg == 3 ? qb : seg == 5 ? ib : gb;
            const bool act = (seg == 3 || seg == 6); const float sc = seg == 0 ? QSCALE : 1.f;
#pragma unroll
            for (int ai = 0; ai < 2; ++ai)
#pragma unroll
                for (int m = 0; m < 4; ++m) {
                    bf16_t* rp = base + (size_t)(row0 + ai * 128 + m * 16) * AWID + colt;
#pragma unroll
                    for (int bj = 0; bj < 2; ++bj) {
                        f32x4 v0 = acc[ai][bj][m][0], v1 = acc[ai][bj][m][1];
                        if (act) {
#pragma unroll
                            for (int i = 0; i < 4; ++i) { v0[i] = silu_f(v0[i]); v1[i] = silu_f(v1[i]); }
                        }
                        v0 = v0 * sc; v1 = v1 * sc;
                        u32x4 w; w.x = pk2(v0[0], v0[1]); w.y = pk2(v0[2], v0[3]); w.z = pk2(v1[0], v1[1]); w.w = pk2(v1[2], v1[3]);
                        *(u32x4*)(rp + bj * 128) = w;
                    }
                }
        }
    }
};
struct EpiResid {
    static constexpr bool PERM = true, AFTER_DRAIN = false;
    const float* base; const float* gate; float* out;
    __device__ __forceinline__ void operator()(const f32x4 (&acc)[2][2][4][2], const pg8::Unit& u, int wr, int wc, int fr, int fq) const {
        const int row0 = u.pm * 256 + wr * 64 + fr, batch = u.pm >> 3, col0 = u.pn * 256 + wc * 32 + 8 * fq;
#pragma unroll
        for (int bj = 0; bj < 2; ++bj) {
            const int c = col0 + bj * 128;
            const f32x4 g0 = *(const f32x4*)(gate + (size_t)batch * NMOD + c), g1 = *(const f32x4*)(gate + (size_t)batch * NMOD + c + 4);
#pragma unroll
            for (int ai = 0; ai < 2; ++ai)
#pragma unroll
                for (int m = 0; m < 4; ++m) {
                    const size_t off = (size_t)(row0 + ai * 128 + m * 16) * DM + c;
                    const f32x4 b0 = *(const f32x4*)(base + off), b1 = *(const f32x4*)(base + off + 4);
                    *(f32x4*)(out + off) = b0 * ALPHA + g0 * acc[ai][bj][m][0];
                    *(f32x4*)(out + off + 4) = b1 * ALPHA + g1 * acc[ai][bj][m][1];
                }
        }
    }
};
struct EpiSwiglu {
    static constexpr bool PERM = true, AFTER_DRAIN = false;
    bf16_t* U;
    __device__ __forceinline__ void operator()(const f32x4 (&acc)[2][2][4][2], const pg8::Unit& u, int wr, int wc, int fr, int fq) const {
        const int row0 = u.pm * 256 + wr * 64 + fr, col0 = u.pn * 128 + wc * 32 + 8 * fq;
#pragma unroll
        for (int ai = 0; ai < 2; ++ai)
#pragma unroll
            for (int m = 0; m < 4; ++m) {
                f32x4 r0, r1;
#pragma unroll
                for (int i = 0; i < 4; ++i) { r0[i] = silu_f(acc[ai][0][m][0][i]) * acc[ai][1][m][0][i]; r1[i] = silu_f(acc[ai][0][m][1][i]) * acc[ai][1][m][1][i]; }
                u32x4 w; w.x = pk2(r0[0], r0[1]); w.y = pk2(r0[2], r0[3]); w.z = pk2(r1[0], r1[1]); w.w = pk2(r1[2], r1[3]);
                *(u32x4*)(U + (size_t)(row0 + ai * 128 + m * 16) * DFF + col0) = w;
            }
    }
};

struct Args { const float* in[16]; float* out; unsigned char* ws; int ph_lo, ph_hi; };
struct Ctx { LAS unsigned char* lds; int tid, lane, wave; };
__device__ __forceinline__ Ctx mk_ctx(LAS unsigned char* lds) { Ctx X; int t = threadIdx.x; asm volatile("" : "+v"(t)); X.lds = lds; X.tid = t; X.lane = t & 63; X.wave = __builtin_amdgcn_readfirstlane(t >> 6); return X; }

template <int K> __device__ __forceinline__ f32x4 mma16(const LAS bf16_t* A, int sa, const LAS bf16_t* Bt, int sb, int fr, int fq, f32x4 acc) {
#pragma unroll
    for (int k0 = 0; k0 < K; k0 += 32) {
        const bf16x8 a = *(const LAS bf16x8*)(A + fr * sa + k0 + 8 * fq), b = *(const LAS bf16x8*)(Bt + fr * sb + k0 + 8 * fq);
        acc = __builtin_amdgcn_mfma_f32_16x16x32_bf16(a, b, acc, 0, 0, 0);
    }
    return acc;
}

__device__ __forceinline__ void ph_mod_partial(const Ctx& X, const float* c, const float* w_ada, float* modp) {
    LAS float* red = (LAS float*)X.lds;
    for (int item = blockIdx.x; item < 768; item += gridDim.x) {
        const int ks = item / 48, cb = item % 48, k0 = ks * 128 + X.wave * 16;
        const float* wp = w_ada + (size_t)k0 * NMOD + cb * 256 + X.lane * 4;
        f32x4 w[16];
#pragma unroll
        for (int i = 0; i < 16; ++i) w[i] = __builtin_nontemporal_load((const f32x4*)(wp + (size_t)i * NMOD));
        LAS float* cvs = (LAS float*)(X.lds + 32768) + X.wave * 64;
        { const int b = X.lane >> 4; const float v = c[b * DM + k0 + (X.lane & 15)]; cvs[X.lane] = v / (1.f + __expf(-v)); }
        f32x4 acc[4];
#pragma unroll
        for (int b = 0; b < 4; ++b) acc[b] = (f32x4){0.f, 0.f, 0.f, 0.f};
#pragma unroll
        for (int i = 0; i < 16; ++i) {
#pragma unroll
            for (int b = 0; b < 4; ++b) { const float s = cvs[b * 16 + i]; acc[b] += w[i] * s; }
        }
#pragma unroll
        for (int b = 0; b < 4; ++b) *(LAS f32x4*)(red + (X.wave * 4 + b) * 256 + X.lane * 4) = acc[b];
        __syncthreads();
#pragma unroll
        for (int k = 0; k < 2; ++k) { const int o = X.tid + NTHR * k, b = o >> 8, cc = o & 255; float s = 0.f;
#pragma unroll
            for (int w8 = 0; w8 < 8; ++w8) s += red[(w8 * 4 + b) * 256 + cc];
            modp[(size_t)(ks * 4 + b) * NMOD + cb * 256 + cc] = s; }
        __syncthreads();
    }
}

__device__ __forceinline__ float mod_value(const float* modp, const float* b_ada, int batch, int mc) {
    float s = b_ada[mc];
#pragma unroll
    for (int ks = 0; ks < 16; ++ks) s += modp[(size_t)(ks * 4 + batch) * NMOD + mc];
    return s;
}
__device__ __forceinline__ void ln_norm8(f32x4 (&v)[8]) {
    float s = 0.f;
#pragma unroll
    for (int j = 0; j < 8; ++j) s += (v[j][0] + v[j][1]) + (v[j][2] + v[j][3]);
    const float mean = wave_sum(s) * (1.f / DM); float q = 0.f;
#pragma unroll
    for (int j = 0; j < 8; ++j) { v[j] = v[j] - mean; q += (v[j][0] * v[j][0] + v[j][1] * v[j][1]) + (v[j][2] * v[j][2] + v[j][3] * v[j][3]); }
    const float rstd = 1.f / sqrtf(wave_sum(q) * (1.f / DM) + LN_EPS);
#pragma unroll
    for (int j = 0; j < 8; ++j) v[j] = v[j] * rstd;
}
__device__ __forceinline__ void ph_h1(const Ctx& X, const float* x, const float* modp, const float* b_ada, bf16_t* h) {
    LAS float* tab = (LAS float*)X.lds;
    for (int rb = blockIdx.x; rb < 256; rb += gridDim.x) {
        const int batch = rb >> 6;
        for (int i = X.tid; i < 4096; i += NTHR) { const float s = mod_value(modp, b_ada, batch, i); tab[i] = (i >= 2048) ? 1.f + s : s; }
        __syncthreads();
        for (int r = X.wave; r < 32; r += 8) {
            const size_t row = (size_t)rb * 32 + r; const float* xr = x + row * DM + 4 * X.lane;
            f32x4 v[8];
#pragma unroll
            for (int j = 0; j < 8; ++j) v[j] = *(const f32x4*)(xr + 256 * j);
            ln_norm8(v);
            bf16_t* hr = h + row * DM + 4 * X.lane;
#pragma unroll
            for (int j = 0; j < 8; ++j) {
                const int c = 4 * X.lane + 256 * j; const f32x4 sh = *(const LAS f32x4*)(tab + c), sc = *(const LAS f32x4*)(tab + 2048 + c);
                const f32x4 o = v[j] * sc + sh; u32x2 w; w.x = pk2(o[0], o[1]); w.y = pk2(o[2], o[3]); *(u32x2*)(hr + 256 * j) = w;
            }
        }
        __syncthreads();
    }
}
__device__ __forceinline__ int ffi_row(int c) { const int cc = c < DFF ? c : c - DFF; return ((cc >> 7) << 8) + (c < DFF ? 0 : 128) + (cc & 127); }
__device__ __forceinline__ void transpose_item(const float* W, int K, int N, bf16_t* WT, bool ffi, LAS float* scr, int item, int lane) {
    const int nblk = N / 32, kb = item / nblk, nb = item % nblk, k0 = 64 * kb, n0 = 32 * nb;
    const int r0 = ffi ? ffi_row(n0) : n0;
    f32x4 v[8];
    const float* wp = W + (size_t)(k0 + (lane >> 3)) * N + n0 + 4 * (lane & 7);
#pragma unroll
    for (int i = 0; i < 8; ++i) v[i] = __builtin_nontemporal_load((const f32x4*)(wp + (size_t)(8 * i) * N));
#pragma unroll
    for (int i = 0; i < 8; ++i) { LAS float* d = scr + (8 * i + (lane >> 3)) * 33 + 4 * (lane & 7); d[0] = v[i][0]; d[1] = v[i][1]; d[2] = v[i][2]; d[3] = v[i][3]; }
    asm volatile("s_waitcnt lgkmcnt(0)" ::: "memory");
    const int c = lane & 7;
#pragma unroll
    for (int j = 0; j < 4; ++j) { const int n = (lane >> 3) + 8 * j; const LAS float* s = scr + (8 * c) * 33 + n;
        u32x4 o; o.x = pk2(s[0 * 33], s[1 * 33]); o.y = pk2(s[2 * 33], s[3 * 33]); o.z = pk2(s[4 * 33], s[5 * 33]); o.w = pk2(s[6 * 33], s[7 * 33]);
        *(u32x4*)(WT + (size_t)(r0 + n) * K + k0 + 8 * c) = o; }
    asm volatile("s_waitcnt lgkmcnt(0)" ::: "memory");
}
__device__ __forceinline__ void ph_weights(const Ctx& X, int mask, int gw, int NGW, const float* w_in, const float* w_o, const float* w_fi, const float* w_fo, bf16_t* win_t, bf16_t* wo_t, bf16_t* wfi_t, bf16_t* wfo_t) {
    LAS float* scr = (LAS float*)(X.lds + X.wave * 16384);
    constexpr int I_IN = (DM / 64) * (NIN / 32), I_O = (DM / 64) * (DM / 32), I_FI = (DM / 64) * (NFF2 / 32), I_FO = (DFF / 64) * (DM / 32);
    const int n_in = (mask & 1) ? I_IN : 0, n_o = (mask & 2) ? I_O : 0, n_fi = (mask & 4) ? I_FI : 0, n_fo = (mask & 8) ? I_FO : 0;
    for (int it = gw; it < n_in + n_o + n_fi + n_fo; it += NGW) {
        int r = it;
        if (r < n_in) { transpose_item(w_in, DM, NIN, win_t, false, scr, r, X.lane); continue; } r -= n_in;
        if (r < n_o) { transpose_item(w_o, DM, DM, wo_t, false, scr, r, X.lane); continue; } r -= n_o;
        if (r < n_fi) { transpose_item(w_fi, DM, NFF2, wfi_t, true, scr, r, X.lane); continue; } r -= n_fi;
        transpose_item(w_fo, DFF, DM, wfo_t, false, scr, r, X.lane);
    }
}
__device__ __forceinline__ void ph_modf(const Ctx& X, const float* modp, const float* b_ada, float* modf) {
    for (int idx = blockIdx.x * NTHR + X.tid; idx < NB * NMOD; idx += gridDim.x * NTHR) { const int b = idx / NMOD, col = idx % NMOD; modf[idx] = mod_value(modp, b_ada, b, col); }
}

__device__ __forceinline__ void attn_unit(const Ctx& X, int b, int h, int c4, const bf16_t* qa, const bf16_t* ka, const bf16_t* va, const float* rel_bias, const float* again, bf16_t* mix) {
    constexpr int KS_OFF = 0, VT_OFF = 18432, TB_OFF = 36864, TILEB = 9216;
    const int lane = X.lane, wave = X.wave, tid = X.tid, r32 = lane & 31, hi = lane >> 5, wq = wave >> 1;
    const int qpos = (4 * c4 + wq) * 64 + (wave & 1) * 32 + r32;
    const size_t qrow = (size_t)b * SEQ + qpos;
    LAS float* tbr = (LAS float*)(X.lds + TB_OFF);
    for (int i = tid; i < 639; i += NTHR) { const int rel = 575 - i; tbr[i] = rel_bias[h * 513 + (rel < 256 ? rel : 256) + 256] * LOG2E; }
    bf16x8 qr[4];
#pragma unroll
    for (int d0 = 0; d0 < 4; ++d0) qr[d0] = *(const bf16x8*)(qa + qrow * AWID + h * 64 + d0 * 16 + hi * 8);
    f32x16 o0, o1;
#pragma unroll
    for (int r = 0; r < 16; ++r) { o0[r] = 0.f; o1[r] = 0.f; }
    float mrun = -1e30f, lrun = 0.f;
    const int tau_lo = (8 - 4 * c4) > 0 ? (8 - 4 * c4) : 0;
    const int krow = tid >> 3, kch = tid & 7, vrow = lane, vch = wave;
    const bf16_t* kbase = ka + ((size_t)b * SEQ + krow) * AWID + h * 64 + kch * 8;
    const bf16_t* vbase = va + ((size_t)b * SEQ + vrow) * AWID + h * 64 + vch * 8;
    u32x4 kreg, vreg;
#define ATT_GLOAD(tau) do { const long kt0_ = (long)(4 * c4 - 8 + (tau)) * 64; kreg = *(const u32x4*)(kbase + kt0_ * AWID); vreg = *(const u32x4*)(vbase + kt0_ * AWID); } while (0)
#define ATT_LSTORE(bufi) do { *(LAS u32x4*)(X.lds + KS_OFF + (bufi) * TILEB + krow * 144 + kch * 16) = kreg; \
        LAS bf16_t* vt_ = (LAS bf16_t*)(X.lds + VT_OFF + (bufi) * TILEB) + (vch * 8) * 72 + vrow; \
        vt_[0 * 72] = (bf16_t)(vreg.x & 0xffffu); vt_[1 * 72] = (bf16_t)(vreg.x >> 16); vt_[2 * 72] = (bf16_t)(vreg.y & 0xffffu); vt_[3 * 72] = (bf16_t)(vreg.y >> 16); \
        vt_[4 * 72] = (bf16_t)(vreg.z & 0xffffu); vt_[5 * 72] = (bf16_t)(vreg.z >> 16); vt_[6 * 72] = (bf16_t)(vreg.w & 0xffffu); vt_[7 * 72] = (bf16_t)(vreg.w >> 16); } while (0)
    ATT_GLOAD(tau_lo); ATT_LSTORE(0);
    __syncthreads();
    int buf = 0;
    for (int tau = tau_lo; tau < 12; ++tau) {
        if (tau + 1 < 12) ATT_GLOAD(tau + 1);
        if (tau >= wq && tau <= wq + 8) {
            f32x16 p0, p1;
#pragma unroll
            for (int r = 0; r < 16; ++r) { p0[r] = 0.f; p1[r] = 0.f; }
            const LAS unsigned char* kb = X.lds + KS_OFF + buf * TILEB + r32 * 144 + hi * 16;
#pragma unroll
            for (int d0 = 0; d0 < 4; ++d0) {
                const bf16x8 k0 = *(const LAS bf16x8*)(kb + d0 * 32), k1 = *(const LAS bf16x8*)(kb + 32 * 144 + d0 * 32);
                p0 = __builtin_amdgcn_mfma_f32_32x32x16_bf16(k0, qr[d0], p0, 0, 0, 0);
                p1 = __builtin_amdgcn_mfma_f32_32x32x16_bf16(k1, qr[d0], p1, 0, 0, 0);
            }
            const int kt0 = (4 * c4 - 8 + tau) * 64;
            const LAS float* tb = tbr + (575 - qpos + kt0 + 4 * hi);
            float mx = -1e30f;
#pragma unroll
            for (int r = 0; r < 16; ++r) { const int off = (r & 3) + 8 * (r >> 2); p0[r] += tb[off]; p1[r] += tb[off + 32]; mx = fmaxf(mx, fmaxf(p0[r], p1[r])); }
            mx = fmaxf(mx, __shfl_xor(mx, 32));
            const float mn = fmaxf(mrun, mx), al = __builtin_amdgcn_exp2f(mrun - mn); mrun = mn;
            float ls = 0.f;
#pragma unroll
            for (int r = 0; r < 16; ++r) { p0[r] = __builtin_amdgcn_exp2f(p0[r] - mn); p1[r] = __builtin_amdgcn_exp2f(p1[r] - mn); ls += p0[r] + p1[r]; }
            lrun = lrun * al + ls;
#pragma unroll
            for (int r = 0; r < 16; ++r) { o0[r] *= al; o1[r] *= al; }
            u32x4 pw[4];
            pw[0] = (u32x4){pk2(p0[0], p0[1]), pk2(p0[2], p0[3]), pk2(p0[4], p0[5]), pk2(p0[6], p0[7])};
            pw[1] = (u32x4){pk2(p0[8], p0[9]), pk2(p0[10], p0[11]), pk2(p0[12], p0[13]), pk2(p0[14], p0[15])};
            pw[2] = (u32x4){pk2(p1[0], p1[1]), pk2(p1[2], p1[3]), pk2(p1[4], p1[5]), pk2(p1[6], p1[7])};
            pw[3] = (u32x4){pk2(p1[8], p1[9]), pk2(p1[10], p1[11]), pk2(p1[12], p1[13]), pk2(p1[14], p1[15])};
            const LAS unsigned char* vb = X.lds + VT_OFF + buf * TILEB + r32 * 144 + hi * 8;
#pragma unroll
            for (int kb4 = 0; kb4 < 4; ++kb4) {
                const s16x4 a0l = *(const LAS s16x4*)(vb + kb4 * 32), a0h = *(const LAS s16x4*)(vb + kb4 * 32 + 16);
                const s16x4 a1l = *(const LAS s16x4*)(vb + 32 * 144 + kb4 * 32), a1h = *(const LAS s16x4*)(vb + 32 * 144 + kb4 * 32 + 16);
                const bf16x8 a0 = (bf16x8){a0l[0], a0l[1], a0l[2], a0l[3], a0h[0], a0h[1], a0h[2], a0h[3]};
                const bf16x8 a1 = (bf16x8){a1l[0], a1l[1], a1l[2], a1l[3], a1h[0], a1h[1], a1h[2], a1h[3]};
                const bf16x8 pf = __builtin_bit_cast(bf16x8, pw[kb4]);
                o0 = __builtin_amdgcn_mfma_f32_32x32x16_bf16(a0, pf, o0, 0, 0, 0);
                o1 = __builtin_amdgcn_mfma_f32_32x32x16_bf16(a1, pf, o1, 0, 0, 0);
            }
        }
        if (tau + 1 < 12) ATT_LSTORE(buf ^ 1);
        __syncthreads();
        buf ^= 1;
    }
#undef ATT_GLOAD
#undef ATT_LSTORE
    lrun += __shfl_xor(lrun, 32);
    const float inv = 1.f / lrun; float ss = 0.f;
#pragma unroll
    for (int r = 0; r < 16; ++r) { o0[r] *= inv; o1[r] *= inv; ss += o0[r] * o0[r] + o1[r] * o1[r]; }
    ss += __shfl_xor(ss, 32);
    const float rs = 1.f / sqrtf(ss * (1.f / 64.f) + LN_EPS);
    bf16_t* orow = mix + qrow * DM + h * 64;
#pragma unroll
    for (int rg = 0; rg < 4; ++rg) {
        const int d = 8 * rg + 4 * hi;
        const f32x4 g0 = *(const f32x4*)(again + h * 64 + d), g1 = *(const f32x4*)(again + h * 64 + 32 + d);
        u32x2 w0, w1;
        w0.x = pk2(o0[4 * rg + 0] * rs * g0[0], o0[4 * rg + 1] * rs * g0[1]); w0.y = pk2(o0[4 * rg + 2] * rs * g0[2], o0[4 * rg + 3] * rs * g0[3]);
        w1.x = pk2(o1[4 * rg + 0] * rs * g1[0], o1[4 * rg + 1] * rs * g1[1]); w1.y = pk2(o1[4 * rg + 2] * rs * g1[2], o1[4 * rg + 3] * rs * g1[3]);
        *(u32x2*)(orow + d) = w0; *(u32x2*)(orow + 32 + d) = w1;
    }
}

__device__ __forceinline__ void hgrnA_unit(const Ctx& X, int b, int h, int n, bf16_t* qb, const float* gl, const bf16_t* ib, float* ointra, bf16_t* U, float* adec) {
    constexpr int QS = 0, KS = 17408, K2T = 34816, IT = 53248, SC = 71680, SEG = 80896;
    LAS bf16_t* Qs = (LAS bf16_t*)(X.lds + QS); LAS bf16_t* Ks = (LAS bf16_t*)(X.lds + KS); LAS bf16_t* K2t = (LAS bf16_t*)(X.lds + K2T);
    LAS bf16_t* It = (LAS bf16_t*)(X.lds + IT); LAS bf16_t* Sc = (LAS bf16_t*)(X.lds + SC); LAS float* segsum = (LAS float*)(X.lds + SEG);
    const int tid = X.tid, lane = X.lane, wave = X.wave, fr = lane & 15, fq = lane >> 4;
    const size_t row0 = (size_t)b * SEQ + n * 64; const int cid = (b * 8 + h) * 32 + n;
    const int d4 = (tid & 31) * 4, ts = tid >> 5;
    f32x4 g[4], bb[4]; u32x2 qraw[4];
#pragma unroll
    for (int i = 0; i < 4; ++i) { const size_t ro = (row0 + 4 * ts + i) * AWID + h * 128 + d4; g[i] = *(const f32x4*)(gl + ro); qraw[i] = *(const u32x2*)(qb + ro); }
    u32x4 iv[2];
#pragma unroll
    for (int k = 0; k < 2; ++k) { const int p = tid + NTHR * k, s_ = p & 63, ch = p >> 6; iv[k] = *(const u32x4*)(ib + (row0 + s_) * AWID + h * 128 + ch * 8); }
    f32x4 run = (f32x4){0.f, 0.f, 0.f, 0.f};
#pragma unroll
    for (int i = 0; i < 4; ++i) { run += g[i]; bb[i] = run; }
    *(LAS f32x4*)(segsum + ts * 128 + d4) = run;
#pragma unroll
    for (int k = 0; k < 2; ++k) {
        const int p = tid + NTHR * k, s_ = p & 63, ch = p >> 6; const u32x4 v = iv[k];
        LAS bf16_t* it_ = It + (ch * 8) * 72 + s_;
        it_[0 * 72] = (bf16_t)(v.x & 0xffffu); it_[1 * 72] = (bf16_t)(v.x >> 16); it_[2 * 72] = (bf16_t)(v.y & 0xffffu); it_[3 * 72] = (bf16_t)(v.y >> 16);
        it_[4 * 72] = (bf16_t)(v.z & 0xffffu); it_[5 * 72] = (bf16_t)(v.z >> 16); it_[6 * 72] = (bf16_t)(v.w & 0xffffu); it_[7 * 72] = (bf16_t)(v.w >> 16);
    }
    __syncthreads();
    f32x4 off = (f32x4){0.f, 0.f, 0.f, 0.f}, tot = off;
#pragma unroll
    for (int s_ = 0; s_ < 16; ++s_) { const f32x4 v = *(const LAS f32x4*)(segsum + s_ * 128 + d4); tot += v; if (s_ < ts) off += v; }
    f32x4 etot;
#pragma unroll
    for (int j = 0; j < 4; ++j) etot[j] = fast_exp(tot[j]);
    f32x4 k2[4];
#pragma unroll
    for (int i = 0; i < 4; ++i) {
        const int t = 4 * ts + i; const f32x4 bv = bb[i] + off; f32x4 qt, kt;
        const float q0 = bflo(qraw[i].x), q1 = bfhi(qraw[i].x), q2 = bflo(qraw[i].y), q3 = bfhi(qraw[i].y);
        qt[0] = q0 * fast_exp(bv[0]); qt[1] = q1 * fast_exp(bv[1]); qt[2] = q2 * fast_exp(bv[2]); qt[3] = q3 * fast_exp(bv[3]);
#pragma unroll
        for (int j = 0; j < 4; ++j) { const float kk = 1.f - fast_exp(g[i][j]); kt[j] = kk * fast_exp(-bv[j]); k2[i][j] = kt[j] * etot[j]; }
        u32x2 wq_, wk_; wq_.x = pk2(qt[0], qt[1]); wq_.y = pk2(qt[2], qt[3]); wk_.x = pk2(kt[0], kt[1]); wk_.y = pk2(kt[2], kt[3]);
        *(LAS u32x2*)(Qs + t * 136 + d4) = wq_; *(u32x2*)(qb + (row0 + t) * AWID + h * 128 + d4) = wq_;
        *(LAS u32x2*)(Ks + t * 136 + d4) = wk_;
    }
#pragma unroll
    for (int j = 0; j < 4; ++j) { u32x2 w; w.x = pk2(k2[0][j], k2[1][j]); w.y = pk2(k2[2][j], k2[3][j]); *(LAS u32x2*)(K2t + (d4 + j) * 72 + 4 * ts) = w; }
    if (ts == 0) *(f32x4*)(adec + (size_t)cid * 128 + d4) = etot;
    __syncthreads();
    {
        const int sb = wave >> 1;
#pragma unroll
        for (int k = 0; k < 2; ++k) {
            const int tb = (wave & 1) * 2 + k; f32x4 acc = (f32x4){0.f, 0.f, 0.f, 0.f};
            if (tb >= sb) {
                acc = mma16<128>(Ks + sb * 16 * 136, 136, Qs + tb * 16 * 136, 136, fr, fq, acc);
                const int t_ = 16 * tb + fr, s_ = 16 * sb + 4 * fq;
#pragma unroll
                for (int j = 0; j < 4; ++j) if (s_ + j > t_) acc[j] = 0.f;
            }
            u32x2 w; w.x = pk2(acc[0], acc[1]); w.y = pk2(acc[2], acc[3]);
            *(LAS u32x2*)(Sc + (16 * tb + fr) * 72 + 16 * sb + 4 * fq) = w;
        }
    }
    __syncthreads();
    {
        const int tb = wave & 3;
#pragma unroll
        for (int k = 0; k < 4; ++k) {
            const int eb = (wave >> 2) * 4 + k; f32x4 acc = (f32x4){0.f, 0.f, 0.f, 0.f};
            acc = mma16<64>(It + eb * 16 * 72, 72, Sc + tb * 16 * 72, 72, fr, fq, acc);
            *(f32x4*)(ointra + (row0 + 16 * tb + fr) * AWID + h * 128 + 16 * eb + 4 * fq) = acc;
        }
    }
    {
        bf16_t* Uc = U + (size_t)cid * 16384;
#pragma unroll
        for (int eb = 0; eb < 8; ++eb) {
            f32x4 acc = (f32x4){0.f, 0.f, 0.f, 0.f};
            acc = mma16<64>(K2t + wave * 16 * 72, 72, It + eb * 16 * 72, 72, fr, fq, acc);
            u32x2 w; w.x = pk2(acc[0], acc[1]); w.y = pk2(acc[2], acc[3]);
            *(u32x2*)(Uc + (16 * eb + fr) * 128 + 16 * wave + 4 * fq) = w;
        }
    }
    __syncthreads();
}

__device__ __forceinline__ void ph_scan(const Ctx& X, const bf16_t* U, const float* adec, bf16_t* Sp) {
    for (int item = blockIdx.x; item < 256; item += gridDim.x) {
        const int bh = item >> 3, sl = item & 7, e = sl * 16 + (X.tid >> 5), d4 = (X.tid & 31) * 4;
        f32x4 S = (f32x4){0.f, 0.f, 0.f, 0.f};
#pragma unroll 4
        for (int n = 0; n < 32; ++n) {
            const int cid = bh * 32 + n; const size_t off = (size_t)cid * 16384 + e * 128 + d4;
            u32x2 w; w.x = pk2(S[0], S[1]); w.y = pk2(S[2], S[3]);
            *(u32x2*)(Sp + off) = w;
            const u32x2 uu = *(const u32x2*)(U + off); const f32x4 a = *(const f32x4*)(adec + (size_t)cid * 128 + d4);
            S[0] = a[0] * S[0] + bflo(uu.x); S[1] = a[1] * S[1] + bfhi(uu.x); S[2] = a[2] * S[2] + bflo(uu.y); S[3] = a[3] * S[3] + bfhi(uu.y);
        }
    }
}

__device__ __forceinline__ void hgrnC_unit(const Ctx& X, int b, int h, int n, const bf16_t* qb, const bf16_t* Sp, const float* ointra, const bf16_t* gb, const float* gng, bf16_t* mix) {
    constexpr int SS = 0, QS = 34816, SSQ = 52224;
    LAS bf16_t* Ss = (LAS bf16_t*)(X.lds + SS); LAS bf16_t* Qs = (LAS bf16_t*)(X.lds + QS); LAS float* ssq = (LAS float*)(X.lds + SSQ);
    const int tid = X.tid, lane = X.lane, wave = X.wave, fr = lane & 15, fq = lane >> 4;
    const size_t row0 = (size_t)b * SEQ + n * 64; const int cid = (b * 8 + h) * 32 + n;
#pragma unroll
    for (int k = 0; k < 4; ++k) { const int p = tid + NTHR * k, e = p >> 4, ch = p & 15; *(LAS u32x4*)(Ss + e * 136 + ch * 8) = *(const u32x4*)(Sp + (size_t)cid * 16384 + e * 128 + ch * 8); }
#pragma unroll
    for (int k = 0; k < 2; ++k) { const int p = tid + NTHR * k, t = p >> 4, ch = p & 15; *(LAS u32x4*)(Qs + t * 136 + ch * 8) = *(const u32x4*)(qb + (row0 + t) * AWID + h * 128 + ch * 8); }
    __syncthreads();
    const int tb = wave & 3, eh = wave >> 2; const size_t row = row0 + 16 * tb + fr;
    f32x4 acc[4]; float ss = 0.f;
#pragma unroll
    for (int k = 0; k < 4; ++k) {
        const int eb = eh * 4 + k;
        acc[k] = *(const f32x4*)(ointra + row * AWID + h * 128 + 16 * eb + 4 * fq);
        acc[k] = mma16<128>(Ss + eb * 16 * 136, 136, Qs + tb * 16 * 136, 136, fr, fq, acc[k]);
        ss += (acc[k][0] * acc[k][0] + acc[k][1] * acc[k][1]) + (acc[k][2] * acc[k][2] + acc[k][3] * acc[k][3]);
    }
    ss += __shfl_xor(ss, 16); ss += __shfl_xor(ss, 32);
    if (fq == 0) ssq[eh * 64 + 16 * tb + fr] = ss;
    __syncthreads();
    const float tot = ssq[16 * tb + fr] + ssq[64 + 16 * tb + fr], rs = 1.f / sqrtf(tot * (1.f / 128.f) + LN_EPS);
#pragma unroll
    for (int k = 0; k < 4; ++k) {
        const int e0 = 16 * (eh * 4 + k) + 4 * fq;
        const f32x4 gg = *(const f32x4*)(gng + e0); const u32x2 sg = *(const u32x2*)(gb + row * AWID + h * 128 + e0);
        u32x2 w;
        w.x = pk2(acc[k][0] * rs * gg[0] * bflo(sg.x), acc[k][1] * rs * gg[1] * bfhi(sg.x));
        w.y = pk2(acc[k][2] * rs * gg[2] * bflo(sg.y), acc[k][3] * rs * gg[3] * bfhi(sg.y));
        *(u32x2*)(mix + row * DM + 1024 + h * 128 + e0) = w;
    }
    __syncthreads();
}

__device__ __forceinline__ void ph_rows1(const Ctx& X, const float* y1, const float* ln_g, const float* ln_b, const float* modf, float* x1, bf16_t* h2) {
    LAS float* tab = (LAS float*)X.lds;
    for (int rb = blockIdx.x; rb < 256; rb += gridDim.x) {
        const int batch = rb >> 6;
        for (int i = X.tid; i < 2048; i += NTHR) { tab[i] = ln_g[i]; tab[2048 + i] = ln_b[i]; tab[4096 + i] = 1.f + modf[(size_t)batch * NMOD + 4 * DM + i]; tab[6144 + i] = modf[(size_t)batch * NMOD + 3 * DM + i]; }
        __syncthreads();
        for (int r = X.wave; r < 32; r += 8) {
            const size_t row = (size_t)rb * 32 + r; const float* yr = y1 + row * DM + 4 * X.lane;
            f32x4 v[8];
#pragma unroll
            for (int j = 0; j < 8; ++j) v[j] = *(const f32x4*)(yr + 256 * j);
            ln_norm8(v);
            float* xr = x1 + row * DM + 4 * X.lane;
#pragma unroll
            for (int j = 0; j < 8; ++j) { const int c = 4 * X.lane + 256 * j; v[j] = v[j] * *(const LAS f32x4*)(tab + c) + *(const LAS f32x4*)(tab + 2048 + c); *(f32x4*)(xr + 256 * j) = v[j]; }
            ln_norm8(v);
            bf16_t* hr = h2 + row * DM + 4 * X.lane;
#pragma unroll
            for (int j = 0; j < 8; ++j) { const int c = 4 * X.lane + 256 * j; const f32x4 o = v[j] * *(const LAS f32x4*)(tab + 4096 + c) + *(const LAS f32x4*)(tab + 6144 + c);
                u32x2 w; w.x = pk2(o[0], o[1]); w.y = pk2(o[2], o[3]); *(u32x2*)(hr + 256 * j) = w; }
        }
        __syncthreads();
    }
}
__device__ __forceinline__ void ph_rows2(const Ctx& X, float* y2, const float* ln_g, const float* ln_b) {
    LAS float* tab = (LAS float*)X.lds;
    for (int i = X.tid; i < 2048; i += NTHR) { tab[i] = ln_g[i]; tab[2048 + i] = ln_b[i]; }
    __syncthreads();
    for (int row = blockIdx.x * 8 + X.wave; row < MROWS; row += gridDim.x * 8) {
        float* yr = y2 + (size_t)row * DM + 4 * X.lane;
        f32x4 v[8];
#pragma unroll
        for (int j = 0; j < 8; ++j) v[j] = *(const f32x4*)(yr + 256 * j);
        ln_norm8(v);
#pragma unroll
        for (int j = 0; j < 8; ++j) { const int c = 4 * X.lane + 256 * j; *(f32x4*)(yr + 256 * j) = v[j] * *(const LAS f32x4*)(tab + c) + *(const LAS f32x4*)(tab + 2048 + c); }
    }
    __syncthreads();
}

#define XB_TMO      128
#define XB_XCNT(j)  (256  + 64 * (j))
#define XB_XSUB(j)  (1280 + 64 * (j))
#define XB_XGEN(j)  (2304 + 64 * (j))
#define XB_TOP      3328
#define XB_TOPGEN   3392
#define XCD_BAR_WORDS 3456
#define XB_SPIN_CAP (1u << 18)

__device__ __forceinline__ unsigned xb_ld(unsigned* p)              { return __hip_atomic_load(p, __ATOMIC_RELAXED, __HIP_MEMORY_SCOPE_AGENT); }
__device__ __forceinline__ unsigned xb_add(unsigned* p, unsigned v) { return __hip_atomic_fetch_add(p, v, __ATOMIC_RELAXED, __HIP_MEMORY_SCOPE_AGENT); }
__device__ __forceinline__ unsigned xb_xcc_id() { return (unsigned)__builtin_amdgcn_s_getreg((3 << 11) | 20) & 0xFu; }
#define XB_SPIN(cond, bar) do { unsigned _sp = 0; while (cond) { __builtin_amdgcn_s_sleep(1); \
    if ((++_sp & 255u) == 0u) { if (xb_ld(&(bar)[XB_TMO])) break; if (_sp > XB_SPIN_CAP) { atomicAdd(&(bar)[XB_TMO], 1u); break; } } } } while (0)

struct XcdBarrier {
    unsigned* bar; unsigned x;
    volatile LAS unsigned* st;
};

__device__ __forceinline__ XcdBarrier xcd_barrier_post(unsigned* bar, volatile LAS unsigned* st) {
    XcdBarrier b; b.bar = bar; b.x = xb_xcc_id(); b.st = st;
    if (threadIdx.x == 0) (void)xb_add(&bar[XB_XCNT(b.x)], 1u);
    return b;
}
__device__ __forceinline__ void xcd_barrier_complete(unsigned* bar, unsigned x, unsigned& nloc, unsigned& nx) {
    const unsigned G = gridDim.x * gridDim.y * gridDim.z;
    unsigned sum, cnt, mine, sp = 0u;
    for (;;) {
        sum = 0u; cnt = 0u; mine = 0u;
#pragma unroll
        for (unsigned j = 0; j < 16; ++j) { const unsigned c = xb_ld(&bar[XB_XCNT(j)]); sum += c; cnt += (c > 0u) ? 1u : 0u; mine = (j == x) ? c : mine; }
        if (sum == G) break;
        __builtin_amdgcn_s_sleep(1);
        if ((++sp & 255u) == 0u) { if (xb_ld(&bar[XB_TMO])) break; if (sp > XB_SPIN_CAP) { atomicAdd(&bar[XB_TMO], 1u); break; } }
    }
    nloc = mine > 0u ? mine : 1u; nx = cnt > 0u ? cnt : 1u;
}

__device__ __forceinline__ void xcd_barrier(const XcdBarrier& b) {
    asm volatile("s_waitcnt vmcnt(0)" ::: "memory");
    __syncthreads();
    if (threadIdx.x == 0) {
        unsigned* bar = b.bar;
        __builtin_amdgcn_s_waitcnt(0);
        unsigned nloc = b.st[0], nx = b.st[1];
        if (nloc == 0u) { xcd_barrier_complete(bar, b.x, nloc, nx); b.st[0] = nloc; b.st[1] = nx; }
        const unsigned old = xb_add(&bar[XB_XSUB(b.x)], 1u);
        const unsigned gen = old / nloc;
        if (old + 1u == (gen + 1u) * nloc) {
            __builtin_amdgcn_fence(__ATOMIC_RELEASE, "agent");
            asm volatile("s_waitcnt vmcnt(0)" ::: "memory");
            const unsigned og = xb_add(&bar[XB_TOP], 1u);
            const unsigned tg = og / nx;
            if (og + 1u == (tg + 1u) * nx) xb_add(&bar[XB_TOPGEN], 1u);
            else XB_SPIN(xb_ld(&bar[XB_TOPGEN]) == tg, bar);
            __builtin_amdgcn_fence(__ATOMIC_ACQUIRE, "agent");
            xb_add(&bar[XB_XGEN(b.x)], 1u);
            asm volatile("s_waitcnt vmcnt(0)" ::: "memory");
        } else {
            XB_SPIN(xb_ld(&bar[XB_XGEN(b.x)]) == gen, bar);
            __builtin_amdgcn_fence(__ATOMIC_ACQUIRE, "agent");
            asm volatile("s_waitcnt vmcnt(0)" ::: "memory");
        }
    }
    __syncthreads();
}

constexpr int N_PHASES = 11;
constexpr int BAR_LDS_OFF = 131072 + 64;
constexpr size_t CTL_ZERO_BYTES = 16384;
#ifndef MK_PER_PHASE
#define MK_PER_PHASE 0
#endif
#ifndef PROBE_PHASE
#define PROBE_PHASE -1
#endif
#ifndef PROBE_MASK
#define PROBE_MASK 0
#endif
#define PROBE_T0(k) do { if ((PROBE_MASK >> (k)) & 1) pt0_ = __builtin_amdgcn_s_memrealtime(); } while (0)
#define PROBE_DLY(k) do { if ((PROBE_MASK >> (k)) & 1) { const unsigned long long t1_ = __builtin_amdgcn_s_memrealtime(), dt_ = t1_ - pt0_; while (__builtin_amdgcn_s_memrealtime() - t1_ < dt_) __builtin_amdgcn_s_sleep(8); } } while (0)
#define REP(k) for (int rep_ = 0; rep_ < ((PROBE_PHASE == (k)) ? 2 : 1); ++rep_)
__device__ __forceinline__ bool ph_in(int lo, int hi, int k) { asm volatile("" : "+s"(lo), "+s"(hi)); return lo <= k && k < hi; }
__global__ void __launch_bounds__(NTHR, 2) mk_fwd(Args a) {
    extern __shared__ __attribute__((aligned(16))) unsigned char lds_raw[];
    LAS unsigned char* const ldsb = (LAS unsigned char*)lds_raw;
#define X mk_ctx(ldsb)
    unsigned char* ws = a.ws;
    const float *x = a.in[0], *c = a.in[1], *w_ada = a.in[2], *b_ada = a.in[3], *w_in = a.in[4], *rel_bias = a.in[5], *attn_g = a.in[6], *lb_logits = a.in[7], *gnorm_g = a.in[8],
                *w_o = a.in[9], *ln1_g = a.in[10], *ln1_b = a.in[11], *w_fi = a.in[12], *w_fo = a.in[13], *ln2_g = a.in[14], *ln2_b = a.in[15];
    float* modp = (float*)(ws + WS_MODP); float* modf = (float*)(ws + WS_MODF);
    bf16_t *win_t = (bf16_t*)(ws + WS_WIN), *wo_t = (bf16_t*)(ws + WS_WO), *wfi_t = (bf16_t*)(ws + WS_WFI), *wfo_t = (bf16_t*)(ws + WS_WFO);
    float* adec = (float*)(ws + WS_ADEC);
    bf16_t* hbuf = (bf16_t*)(ws + WS_H); float* ointra = (float*)(ws + WS_H);
    bf16_t *qa = (bf16_t*)(ws + WS_QA), *ka = (bf16_t*)(ws + WS_KA), *va = (bf16_t*)(ws + WS_VA), *qb = (bf16_t*)(ws + WS_QB), *ib = (bf16_t*)(ws + WS_IB), *gb = (bf16_t*)(ws + WS_GB);
    float* gl = (float*)(ws + WS_GL);
    bf16_t *mix = (bf16_t*)(ws + WS_MIX), *U = (bf16_t*)(ws + WS_U), *Sp = (bf16_t*)(ws + WS_SP), *uff = (bf16_t*)(ws + WS_UFF);
    float *y1 = (float*)(ws + WS_Y1), *x1 = (float*)(ws + WS_X1);
#define tail_cvt (gridDim.x == 256)
#if MK_PER_PHASE
#define IN(k) ph_in(a.ph_lo, a.ph_hi, (k))
#define SEAM(k) do { } while (0)
#else
#define IN(k) true
#define SEAM(k) do { xcd_barrier(bar); PROBE_DLY(k); PROBE_T0((k) + 1); } while (0)
    unsigned long long pt0_ = 0; PROBE_T0(0);
    if (X.tid < 2) ((volatile LAS unsigned*)(X.lds + BAR_LDS_OFF))[X.tid] = 0u;
    __syncthreads();
    XcdBarrier bar = xcd_barrier_post((unsigned*)ws, (volatile LAS unsigned*)(X.lds + BAR_LDS_OFF));
    if (a.ph_lo == 0x7fffffff) cg::this_grid().sync();
#endif

#if PROBE_PHASE == 99
    for (int pass_ = 0; pass_ < 2; ++pass_) {
#endif
    if (IN(0)) { ph_mod_partial(X, c, w_ada, modp); }
#if PROBE_PHASE == 0
    ph_mod_partial(X, c, w_ada, modp);
#endif
    SEAM(0);
    if (IN(1)) { ph_h1(X, x, modp, b_ada, hbuf); ph_modf(X, modp, b_ada, modf); ph_weights(X, tail_cvt ? 1 : 15, (int)blockIdx.x * 8 + X.wave, (int)gridDim.x * 8, w_in, w_o, w_fi, w_fo, win_t, wo_t, wfi_t, wfo_t); }
#if PROBE_PHASE == 1
    __syncthreads(); ph_h1(X, x, modp, b_ada, hbuf);
#endif
#if PROBE_PHASE == 11
    __syncthreads(); ph_weights(X, tail_cvt ? 1 : 15, (int)blockIdx.x * 8 + X.wave, (int)gridDim.x * 8, w_in, w_o, w_fi, w_fo, win_t, wo_t, wfi_t, wfo_t);
#endif
    SEAM(1);
    if (IN(2)) {
        pg8::Gemm g{hbuf, win_t, MROWS, NIN, DM}; pg8::StaticOrder S; S.init(MROWS, NIN, (int)gridDim.x, (int)blockIdx.x);
        EpiInProj E{qa, ka, va, qb, ib, gb, gl, lb_logits};
        pg8::gemm_phase<EpiInProj, pg8::StaticOrder, true, true>(X.lds, g, S, E);
        if (tail_cvt && blockIdx.x >= 128) ph_weights(X, 2 | 4, ((int)blockIdx.x - 128) * 8 + X.wave, 128 * 8, w_in, w_o, w_fi, w_fo, win_t, wo_t, wfi_t, wfo_t);
    }
#if PROBE_PHASE == 2
    {
        pg8::Gemm g{hbuf, win_t, MROWS, NIN, DM}; pg8::StaticOrder S; S.init(MROWS, NIN, (int)gridDim.x, (int)blockIdx.x);
        EpiInProj E{qa, ka, va, qb, ib, gb, gl, lb_logits};
        pg8::gemm_phase<EpiInProj, pg8::StaticOrder, true, true>(X.lds, g, S, E);
    }
#endif
    SEAM(2);
    if (IN(3)) {
        __syncthreads();
        REP(30) for (int u = blockIdx.x; u < 512; u += gridDim.x) { const int c4 = u & 7, bh = u >> 3; attn_unit(X, bh >> 4, bh & 15, c4, qa, ka, va, rel_bias, attn_g, mix); }
        for (int u = blockIdx.x; u < 1024; u += gridDim.x) { const int n = u & 31, bh = u >> 5; hgrnA_unit(X, bh >> 3, bh & 7, n, qb, gl, ib, ointra, U, adec); }
    } SEAM(3);
    if (IN(4)) { ph_scan(X, U, adec, Sp); }
#if PROBE_PHASE == 4
    ph_scan(X, U, adec, Sp);
#endif
    SEAM(4);
    if (IN(5)) REP(5) {
        for (int u = blockIdx.x; u < 1024; u += gridDim.x) { const int n = u & 31, bh = u >> 5; hgrnC_unit(X, bh >> 3, bh & 7, n, qb, Sp, ointra, gb, gnorm_g, mix); }
    } SEAM(5);
    if (IN(6)) {
        pg8::Gemm g{mix, wo_t, MROWS, DM, DM}; pg8::StaticOrder S; S.init(MROWS, DM, (int)gridDim.x, (int)blockIdx.x);
        EpiResid E{x, modf + 2 * DM, y1};
        pg8::gemm_phase<EpiResid, pg8::StaticOrder, true, true>(X.lds, g, S, E);
    }
#if PROBE_PHASE == 6
    {
        pg8::Gemm g{mix, wo_t, MROWS, DM, DM}; pg8::StaticOrder S; S.init(MROWS, DM, (int)gridDim.x, (int)blockIdx.x);
        EpiResid E{x, modf + 2 * DM, y1};
        pg8::gemm_phase<EpiResid, pg8::StaticOrder, true, true>(X.lds, g, S, E);
    }
#endif
    SEAM(6);
    if (IN(7)) { __syncthreads(); ph_rows1(X, y1, ln1_g, ln1_b, modf, x1, hbuf); }
#if PROBE_PHASE == 7
    ph_rows1(X, y1, ln1_g, ln1_b, modf, x1, hbuf);
#endif
    SEAM(7);
    if (IN(8)) {
        pg8::Gemm g{hbuf, wfi_t, MROWS, NFF2, DM}; pg8::StaticOrder S; S.init(MROWS, NFF2, (int)gridDim.x, (int)blockIdx.x);
        EpiSwiglu E{uff};
        pg8::gemm_phase<EpiSwiglu, pg8::StaticOrder, true, true>(X.lds, g, S, E);
        if (tail_cvt && blockIdx.x >= 128) ph_weights(X, 8, ((int)blockIdx.x - 128) * 8 + X.wave, 128 * 8, w_in, w_o, w_fi, w_fo, win_t, wo_t, wfi_t, wfo_t);
    }
#if PROBE_PHASE == 8
    {
        pg8::Gemm g{hbuf, wfi_t, MROWS, NFF2, DM}; pg8::StaticOrder S; S.init(MROWS, NFF2, (int)gridDim.x, (int)blockIdx.x);
        EpiSwiglu E{uff};
        pg8::gemm_phase<EpiSwiglu, pg8::StaticOrder, true, true>(X.lds, g, S, E);
    }
#endif
    SEAM(8);
    if (IN(9)) {
        pg8::Gemm g{uff, wfo_t, MROWS, DM, DFF}; pg8::StaticOrder S; S.init(MROWS, DM, (int)gridDim.x, (int)blockIdx.x);
        EpiResid E{x1, modf + 5 * DM, a.out};
        pg8::gemm_phase<EpiResid, pg8::StaticOrder, true, true>(X.lds, g, S, E);
    }
#if PROBE_PHASE == 9
    {
        pg8::Gemm g{uff, wfo_t, MROWS, DM, DFF}; pg8::StaticOrder S; S.init(MROWS, DM, (int)gridDim.x, (int)blockIdx.x);
        EpiResid E{x1, modf + 5 * DM, a.out};
        pg8::gemm_phase<EpiResid, pg8::StaticOrder, true, true>(X.lds, g, S, E);
    }
#endif
    SEAM(9);
    if (IN(10)) { __syncthreads(); ph_rows2(X, a.out, ln2_g, ln2_b); PROBE_DLY(10); }
#if PROBE_PHASE == 99
    if (pass_ == 0) xcd_barrier(bar);
    }
#endif
#undef IN
#undef SEAM
#undef X
#undef tail_cvt
}

#ifndef MK_PER_PHASE
#define MK_PER_PHASE 0
#endif
extern "C" void kernel_launch(void* const* d_in, const int* in_sizes, int n_in, void* d_out, int out_size, void* d_ws, size_t ws_size, hipStream_t stream) {
    static int grid = 0;
    if (grid == 0) {
        if (n_in != 16 || in_sizes[0] != MROWS * DM || out_size != MROWS * DM || ws_size < WS_END) {
            fprintf(stderr, "kernel_launch: unexpected shapes (n_in %d, in0 %d, out %d, ws %zu; need ws >= %zu); nothing launched\n", n_in, n_in > 0 ? in_sizes[0] : -1, out_size, ws_size, (size_t)WS_END); grid = -1; return; }
        int dev = 0, cus = 0, per_cu = 0;
        hipGetDevice(&dev); hipDeviceGetAttribute(&cus, hipDeviceAttributeMultiprocessorCount, dev);
        if (hipFuncSetAttribute((const void*)mk_fwd, hipFuncAttributeMaxDynamicSharedMemorySize, LDS_BYTES) != hipSuccess) { fprintf(stderr, "kernel_launch: hipFuncSetAttribute failed\n"); grid = -1; return; }
        if (hipOccupancyMaxActiveBlocksPerMultiprocessor(&per_cu, (const void*)mk_fwd, NTHR, LDS_BYTES) != hipSuccess || per_cu < 1) { fprintf(stderr, "kernel_launch: occupancy query says %d blocks per CU\n", per_cu); (void)hipGetLastError(); grid = -1; return; }
        grid = cus;
    }
    if (grid < 0) return;
    Args a{};
    for (int i = 0; i < 16; ++i) a.in[i] = (const float*)d_in[i];
    a.out = (float*)d_out; a.ws = (unsigned char*)d_ws;
#if MK_PER_PHASE
    for (int p = 0; p < N_PHASES; ++p) {
        a.ph_lo = p; a.ph_hi = p + 1; void* args[] = {&a};
        hipError_t e = hipLaunchCooperativeKernel((const void*)mk_fwd, dim3(grid), dim3(NTHR), args, LDS_BYTES, stream);
        if (e != hipSuccess) { fprintf(stderr, "kernel_launch: launch %d failed: %s\n", p, hipGetErrorString(e)); break; }
    }
#else
    if (hipMemsetAsync(d_ws, 0, CTL_ZERO_BYTES, stream) != hipSuccess) { fprintf(stderr, "kernel_launch: memset of the barrier words failed\n"); return; }
    a.ph_lo = 0; a.ph_hi = N_PHASES; void* args[] = {&a};
    hipError_t e = hipLaunchCooperativeKernel((const void*)mk_fwd, dim3(grid), dim3(NTHR), args, LDS_BYTES, stream);
    if (e != hipSuccess) fprintf(stderr, "kernel_launch: cooperative launch failed: %s (grid %d)\n", hipGetErrorString(e), grid);
#if PROBE_PHASE == 98
    (void)hipMemsetAsync(d_ws, 0, CTL_ZERO_BYTES, stream);
    (void)hipLaunchCooperativeKernel((const void*)mk_fwd, dim3(grid), dim3(NTHR), args, LDS_BYTES, stream);
#endif
#endif
}
```

```cpp
#include <hip/hip_runtime.h>
#include <hip/hip_cooperative_groups.h>
#include <cstdio>
#include <cstdint>
namespace cg = cooperative_groups;
namespace pg8 {
#define PG8_LAS __attribute__((address_space(3)))
typedef unsigned short bf16_t;
typedef short bf16x8 __attribute__((ext_vector_type(8)));
typedef float f32x4 __attribute__((ext_vector_type(4)));
typedef unsigned u32x4 __attribute__((ext_vector_type(4)));
constexpr int BM = 256, BK = 64, HALF = 128, HTB = HALF * BK * 2  , STAGE_BYTES = 8 * HTB, NXCD = 8, WGM = 8;

__host__ __device__ __forceinline__ int lds_byte(int r, int c) { const int st = (r >> 4) * 2 + (c >> 5), rr = r & 15, cc = c & 31, ob = rr * 64 + cc * 2; return st * 1024 + (ob ^ (((ob >> 9) & 1) << 5)); }
__host__ __device__ __forceinline__ void stage_rc(int b, int& R, int& C) { const int st = b / 1024, sb = b % 1024, swz = sb ^ (((sb >> 9) & 1) << 5); R = (st >> 1) * 16 + swz / 64; C = (st & 1) * 32 + (swz % 64) / 2; }
__host__ __device__ __forceinline__ int perm32(int rho) { const int n = rho >> 4, i = rho & 15; return 8 * (i >> 2) + 4 * n + (i & 3); }

struct Unit { int pm, pn; };
struct Gemm { const bf16_t* A; const bf16_t* Bt; int M, N, K; };

struct StaticOrder {
    int nM, nN, nwg, G, c;
    __host__ __device__ void init(int M, int N, int G_, int c_) { nM = M / BM; nN = N / BM; nwg = nM * nN; G = G_; c = c_; }
    __host__ __device__ bool next(int i, Unit& u) const {
        const long L = (long)i * G + c; if (L >= nwg) return false;
        int wgid = (int)L; { const int q = nwg / NXCD, r = nwg % NXCD, xcd = wgid % NXCD, off = wgid / NXCD; wgid = (xcd < r ? xcd * (q + 1) : r * (q + 1) + (xcd - r) * q) + off; }
        const int nig = WGM * nN, gid = wgid / nig, fm = gid * WGM, gsz = (nM - fm) < WGM ? (nM - fm) : WGM;
        u.pm = fm + ((wgid % nig) % gsz); u.pn = (wgid % nig) / gsz; return true;
    }
    __device__ __forceinline__ void a_ready(const Unit&) const {}
    __device__ __forceinline__ void done(const Unit&) const {}
};

template <class Epi, class Sched, bool ALIGN_EPI = false, bool SP2 = false>
__device__ __forceinline__ void gemm_phase(PG8_LAS unsigned char* lds, const Gemm g, const Sched& S, const Epi& E) {
    const int tid = threadIdx.x, wid = __builtin_amdgcn_readfirstlane(tid >> 6), lane = tid & 63, wr = wid >> 2, wc = wid & 3, fr = lane & 15, fq = lane >> 4;
    const int K = g.K, nt = K / BK;
    unsigned voffA[2], voffB[2];
#pragma unroll
    for (int i = 0; i < 2; ++i) { int R, C; stage_rc(tid * 16 + i * 8192, R, C); const int Rb = Epi::PERM ? ((R & ~31) + perm32(R & 31)) : R;
        voffA[i] = (unsigned)(R * K + C) * 2u; voffB[i] = (unsigned)(Rb * K + C) * 2u; }
    const size_t kstep = (size_t)(BK * 2);
    const size_t hstep = (size_t)HALF * K * 2;
    const size_t tstep = 2 * hstep;
    const unsigned ldsw = (unsigned)wid * 1024u;
    const int aoff = lds_byte(wr * 64 + fr, fq * 8), boff = lds_byte(wc * 32 + fr, fq * 8);
#define PG8_SA(b, h) (((b) * 2 + (h)) * HTB)
#define PG8_SB(b, h) ((4 + (b) * 2 + (h)) * HTB)
#define PG8_STAGE(bufoff, gbase, voff) do { _Pragma("unroll") for (int _i = 0; _i < 2; ++_i) \
        __builtin_amdgcn_global_load_lds((const unsigned*)((const char*)(gbase) + (voff)[_i]), (PG8_LAS unsigned*)(lds + (bufoff) + ldsw + _i * 8192), 16, 0, 0); } while (0)
#define PG8_LDA(dst, b, h) do { _Pragma("unroll") for (int m = 0; m < 4; ++m) _Pragma("unroll") for (int k = 0; k < 2; ++k) dst[m][k] = *(const PG8_LAS bf16x8*)(lds + PG8_SA(b, h) + aoff + m * 2048 + k * 1024); } while (0)
#define PG8_LDB(dst, b, h) do { _Pragma("unroll") for (int n = 0; n < 2; ++n) _Pragma("unroll") for (int k = 0; k < 2; ++k) dst[n][k] = *(const PG8_LAS bf16x8*)(lds + PG8_SB(b, h) + boff + n * 2048 + k * 1024); } while (0)
#define PG8_MMA(ai, bj, At, Bt) do { __builtin_amdgcn_s_setprio(1); _Pragma("unroll") for (int m = 0; m < 4; ++m) _Pragma("unroll") for (int n = 0; n < 2; ++n) _Pragma("unroll") for (int k = 0; k < 2; ++k) \
        acc[ai][bj][m][n] = __builtin_amdgcn_mfma_f32_16x16x32_bf16(Bt[n][k], At[m][k], acc[ai][bj][m][n], 0, 0, 0); __builtin_amdgcn_s_setprio(0); } while (0)
#define PG8_WAIT_V(n) asm volatile("s_waitcnt vmcnt(" #n ")" ::: "memory")
#define PG8_WAIT_L(n) asm volatile("s_waitcnt lgkmcnt(" #n ")" ::: "memory")
#define PG8_BAR __builtin_amdgcn_s_barrier()
#define PG8_SCHED __builtin_amdgcn_sched_barrier(0)
    Unit cur, nxt; int ui = 0;
    if (!S.next(0, cur)) return;
    f32x4 acc[2][2][4][2];
#pragma unroll
    for (int a = 0; a < 2; ++a)
#pragma unroll
        for (int b = 0; b < 2; ++b)
#pragma unroll
            for (int m = 0; m < 4; ++m)
#pragma unroll
                for (int n = 0; n < 2; ++n) acc[a][b][m][n] = (f32x4){0.f, 0.f, 0.f, 0.f};
    bf16x8 At[4][2], B0[2][2], B1[2][2];
    const char* cA = (const char*)g.A + (size_t)cur.pm * tstep; const char* cB = (const char*)g.Bt + (size_t)cur.pn * tstep;
    S.a_ready(cur);
    if constexpr (SP2) {
        PG8_STAGE(PG8_SB(0, 0), cB, voffB); PG8_STAGE(PG8_SB(0, 1), cB + hstep, voffB); PG8_STAGE(PG8_SA(0, 0), cA, voffA); PG8_STAGE(PG8_SA(0, 1), cA + hstep, voffA);
        if (wr == 1) PG8_BAR;
        PG8_WAIT_V(2); PG8_BAR;
        PG8_STAGE(PG8_SB(1, 0), cB + kstep, voffB); PG8_STAGE(PG8_SA(1, 0), cA + kstep, voffA); PG8_STAGE(PG8_SB(1, 1), cB + hstep + kstep, voffB);
        PG8_WAIT_V(6); PG8_BAR;
    } else {
        PG8_STAGE(PG8_SB(0, 0), cB, voffB); PG8_STAGE(PG8_SA(0, 0), cA, voffA); PG8_STAGE(PG8_SB(0, 1), cB + hstep, voffB); PG8_STAGE(PG8_SA(0, 1), cA + hstep, voffA);
        if (wr == 1) PG8_BAR;
        PG8_WAIT_V(4); PG8_BAR;
        PG8_STAGE(PG8_SB(1, 0), cB + kstep, voffB); PG8_STAGE(PG8_SA(1, 0), cA + kstep, voffA); PG8_STAGE(PG8_SB(1, 1), cB + hstep + kstep, voffB);
        PG8_WAIT_V(6); PG8_BAR;
    }
    for (;;) {
        const bool has_next = S.next(ui + 1, nxt);
        const char* nA = has_next ? (const char*)g.A + (size_t)nxt.pm * tstep : cA; const char* nB = has_next ? (const char*)g.Bt + (size_t)nxt.pn * tstep : cB;
        for (int t = 0; t < nt; t += 2) {
            const bool last = (t == nt - 2);
            const char* a1 = cA + (size_t)(t + 1) * kstep;
            const char* a2 = last ? nA : cA + (size_t)(t + 2) * kstep; const char* b2 = last ? nB : cB + (size_t)(t + 2) * kstep;
            const char* a3 = a2 + kstep; const char* b3 = b2 + kstep;
            if (last && has_next) S.a_ready(nxt);
            if constexpr (SP2) {
            PG8_LDB(B0, 0, 0); PG8_LDB(B1, 0, 1); PG8_SCHED; PG8_LDA(At, 0, 0); PG8_STAGE(PG8_SA(1, 1), a1 + hstep, voffA);
            PG8_WAIT_V(8); PG8_WAIT_L(0); PG8_BAR; PG8_MMA(0, 0, At, B0); PG8_MMA(0, 1, At, B1); PG8_BAR; PG8_SCHED;
            PG8_LDA(At, 0, 1); PG8_STAGE(PG8_SB(0, 0), b2, voffB); PG8_STAGE(PG8_SB(0, 1), b2 + hstep, voffB); PG8_STAGE(PG8_SA(0, 0), a2, voffA);
            PG8_WAIT_V(8); PG8_WAIT_L(0); PG8_BAR; PG8_MMA(1, 0, At, B0); PG8_MMA(1, 1, At, B1); PG8_BAR; PG8_SCHED;
            PG8_LDB(B0, 1, 0); PG8_LDB(B1, 1, 1); PG8_SCHED; PG8_LDA(At, 1, 0); PG8_STAGE(PG8_SA(0, 1), a2 + hstep, voffA);
            PG8_WAIT_V(8); PG8_WAIT_L(0); PG8_BAR; PG8_MMA(0, 0, At, B0); PG8_MMA(0, 1, At, B1); PG8_BAR; PG8_SCHED;
            PG8_LDA(At, 1, 1); PG8_STAGE(PG8_SB(1, 0), b3, voffB); PG8_STAGE(PG8_SB(1, 1), b3 + hstep, voffB); PG8_STAGE(PG8_SA(1, 0), a3, voffA);
            PG8_WAIT_V(8); PG8_WAIT_L(0); PG8_BAR; PG8_MMA(1, 0, At, B0); PG8_MMA(1, 1, At, B1); PG8_BAR; PG8_SCHED;
            } else {
            PG8_LDB(B0, 0, 0); PG8_SCHED; PG8_LDA(At, 0, 0); PG8_STAGE(PG8_SA(1, 1), a1 + hstep, voffA);
            PG8_WAIT_L(8); PG8_BAR; PG8_WAIT_L(0); PG8_MMA(0, 0, At, B0); PG8_BAR; PG8_SCHED;
            PG8_LDB(B1, 0, 1); PG8_STAGE(PG8_SB(0, 0), b2, voffB);
            PG8_BAR; PG8_WAIT_L(0); PG8_MMA(0, 1, At, B1); PG8_BAR;
            PG8_LDA(At, 0, 1); PG8_STAGE(PG8_SA(0, 0), a2, voffA);
            PG8_BAR; PG8_WAIT_L(0); PG8_MMA(1, 0, At, B0); PG8_BAR; PG8_SCHED;
            PG8_STAGE(PG8_SB(0, 1), b2 + hstep, voffB);
            PG8_WAIT_V(6); PG8_BAR; PG8_MMA(1, 1, At, B1); PG8_BAR;
            PG8_LDB(B0, 1, 0); PG8_SCHED; PG8_LDA(At, 1, 0); PG8_STAGE(PG8_SA(0, 1), a2 + hstep, voffA);
            PG8_WAIT_L(8); PG8_BAR; PG8_WAIT_L(0); PG8_MMA(0, 0, At, B0); PG8_BAR; PG8_SCHED;
            PG8_LDB(B1, 1, 1); PG8_STAGE(PG8_SB(1, 0), b3, voffB);
            PG8_BAR; PG8_WAIT_L(0); PG8_MMA(0, 1, At, B1); PG8_BAR;
            PG8_LDA(At, 1, 1); PG8_STAGE(PG8_SA(1, 0), a3, voffA);
            PG8_BAR; PG8_WAIT_L(0); PG8_MMA(1, 0, At, B0); PG8_BAR; PG8_SCHED;
            PG8_STAGE(PG8_SB(1, 1), b3 + hstep, voffB);
            PG8_WAIT_V(6); PG8_BAR; PG8_MMA(1, 1, At, B1); PG8_BAR;
            }
        }
        if constexpr (ALIGN_EPI) { if (wr == 0) PG8_BAR; }
        if constexpr (!Epi::AFTER_DRAIN) { E(acc, cur, wr, wc, fr, fq); S.done(cur); }
        if (!has_next) break;
#pragma unroll
        for (int a = 0; a < 2; ++a)
#pragma unroll
            for (int b = 0; b < 2; ++b)
#pragma unroll
                for (int m = 0; m < 4; ++m)
#pragma unroll
                    for (int n = 0; n < 2; ++n) acc[a][b][m][n] = (f32x4){0.f, 0.f, 0.f, 0.f};
        cur = nxt; cA = nA; cB = nB; ++ui;
        if constexpr (ALIGN_EPI) { if (wr == 1) PG8_BAR; }
    }
    PG8_WAIT_V(0);
    if constexpr (!ALIGN_EPI) { if (wr == 0) PG8_BAR; }
    PG8_BAR;
    if constexpr (Epi::AFTER_DRAIN) { E.fused(acc, cur, wr, wc, fr, fq, lds, wid, lane); S.done(cur); }
#undef PG8_SA
#undef PG8_SB
#undef PG8_STAGE
#undef PG8_LDA
#undef PG8_LDB
#undef PG8_MMA
#undef PG8_WAIT_V
#undef PG8_WAIT_L
#undef PG8_BAR
#undef PG8_SCHED
}
}

constexpr int NB = 4, SEQ = 2048, DM = 2048, MROWS = NB * SEQ;
constexpr int NIN = 7168, DFF = 5632, NFF2 = 2 * DFF, NMOD = 6 * DM;
constexpr int AWID = 1024;
constexpr float LN_EPS = 1e-5f;
constexpr float ALPHA = 1.189207115002721f;
constexpr float LOG2E = 1.4426950408889634f;
constexpr float QSCALE = 0.125f * LOG2E;

constexpr size_t MiB = 1u << 20;
constexpr size_t WS_MODP = 364 * MiB;
constexpr size_t WS_MODF = 2 * MiB + 1572864;
constexpr size_t WS_WIN = 4 * MiB, WS_WO = 32 * MiB, WS_WFI = 40 * MiB, WS_WFO = 84 * MiB;
constexpr size_t WS_ADEC = 106 * MiB;
constexpr size_t WS_H = 108 * MiB;
constexpr size_t WS_QA = 140 * MiB, WS_KA = 156 * MiB, WS_VA = 172 * MiB, WS_QB = 188 * MiB, WS_IB = 204 * MiB, WS_GB = 220 * MiB;
constexpr size_t WS_GL = 236 * MiB;
constexpr size_t WS_MIX = 268 * MiB;
constexpr size_t WS_U = 300 * MiB, WS_SP = 332 * MiB;
constexpr size_t WS_Y1 = 140 * MiB, WS_X1 = 204 * MiB;
constexpr size_t WS_UFF = 268 * MiB;
constexpr size_t WS_END = 368 * MiB;

constexpr int LDS_BYTES = 147456;
constexpr int NTHR = 512;

#define LAS __attribute__((address_space(3)))
typedef unsigned short bf16_t;
typedef short bf16x8 __attribute__((ext_vector_type(8)));
typedef short s16x4 __attribute__((ext_vector_type(4)));
typedef float f32x4 __attribute__((ext_vector_type(4)));
typedef float f32x2 __attribute__((ext_vector_type(2)));
typedef float f32x16 __attribute__((ext_vector_type(16)));
typedef unsigned u32x4 __attribute__((ext_vector_type(4)));
typedef unsigned u32x2 __attribute__((ext_vector_type(2)));
typedef __bf16 bf16x2_t __attribute__((ext_vector_type(2)));

__device__ __forceinline__ unsigned pk2(float lo, float hi) { f32x2 v = {lo, hi}; bf16x2_t b = __builtin_convertvector(v, bf16x2_t); return __builtin_bit_cast(unsigned, b); }
__device__ __forceinline__ bf16_t f2bf(float x) { return (bf16_t)(pk2(x, 0.f) & 0xffffu); }
__device__ __forceinline__ float bf2f(unsigned v) { return __uint_as_float(v << 16); }
__device__ __forceinline__ float bflo(unsigned w) { return __uint_as_float(w << 16); }
__device__ __forceinline__ float bfhi(unsigned w) { return __uint_as_float(w & 0xffff0000u); }
__device__ __forceinline__ float fast_exp(float x) { return __builtin_amdgcn_exp2f(x * LOG2E); }
__device__ __forceinline__ float silu_f(float x) { return x * __builtin_amdgcn_rcpf(1.f + __builtin_amdgcn_exp2f(-x * LOG2E)); }
__device__ __forceinline__ float wave_sum(float v) {
#pragma unroll
    for (int o = 1; o < 64; o <<= 1) v += __shfl_xor(v, o);
    return v;
}

struct EpiInProj {
    static constexpr bool PERM = true, AFTER_DRAIN = false;
    bf16_t *qa, *ka, *va, *qb, *ib, *gb; float* gl; const float* lbl;
    __device__ __forceinline__ void operator()(const f32x4 (&acc)[2][2][4][2], const pg8::Unit& u, int wr, int wc, int fr, int fq) const {
        const int seg = u.pn >> 2; const int colt = (u.pn & 3) * 256 + wc * 32 + 8 * fq; const int row0 = u.pm * 256 + wr * 64 + fr;
        if (seg == 4) {
#pragma unroll
            for (int bj = 0; bj < 2; ++bj) {
                const int c = colt + bj * 128; float lb[8];
#pragma unroll
                for (int i = 0; i < 8; ++i) { const float l0 = lbl[c + i], l1 = lbl[1024 + c + i]; lb[i] = 1.f / (1.f + __expf(l1 - l0)); }
#pragma unroll
                for (int ai = 0; ai < 2; ++ai)
#pragma unroll
                    for (int m = 0; m < 4; ++m) {
                        float* rp = gl + (size_t)(row0 + ai * 128 + m * 16) * AWID + c; f32x4 o0, o1;
#pragma unroll
                        for (int i = 0; i < 4; ++i) {
                            const float s0 = 1.f / (1.f + __expf(-acc[ai][bj][m][0][i])), s1 = 1.f / (1.f + __expf(-acc[ai][bj][m][1][i]));
                            o0[i] = __logf(lb[i] + (1.f - lb[i]) * s0); o1[i] = __logf(lb[4 + i] + (1.f - lb[4 + i]) * s1);
                        }
                        *(f32x4*)rp = o0; *(f32x4*)(rp + 4) = o1;
                    }
            }
        } else {
            bf16_t* base = seg == 0 ? qa : seg == 1 ? ka : seg == 2 ? va : seg == 3 ? qb : seg == 5 ? ib : gb;
            const bool act = (seg == 3 || seg == 6); const float sc = seg == 0 ? QSCALE : 1.f;
#pragma unroll
            for (int ai = 0; ai < 2; ++ai)
#pragma unroll
                for (int m = 0; m < 4; ++m) {
                    bf16_t* rp = base + (size_t)(row0 + ai * 128 + m * 16) * AWID + colt;
#pragma unroll
                    for (int bj = 0; bj < 2; ++bj) {
                        f32x4 v0 = acc[ai][bj][m][0], v1 = acc[ai][bj][m][1];
                        if (act) {
#pragma unroll
                            for (int i = 0; i < 4; ++i) { v0[i] = silu_f(v0[i]); v1[i] = silu_f(v1[i]); }
                        }
                        v0 = v0 * sc; v1 = v1 * sc;
                        u32x4 w; w.x = pk2(v0[0], v0[1]); w.y = pk2(v0[2], v0[3]); w.z = pk2(v1[0], v1[1]); w.w = pk2(v1[2], v1[3]);
                        *(u32x4*)(rp + bj * 128) = w;
                    }
                }
        }
    }
};
struct EpiResid {
    static constexpr bool PERM = true, AFTER_DRAIN = false;
    const float* base; const float* gate; float* out;
    __device__ __forceinline__ void operator()(const f32x4 (&acc)[2][2][4][2], const pg8::Unit& u, int wr, int wc, int fr, int fq) const {
        const int row0 = u.pm * 256 + wr * 64 + fr, batch = u.pm >> 3, col0 = u.pn * 256 + wc * 32 + 8 * fq;
#pragma unroll
        for (int bj = 0; bj < 2; ++bj) {
            const int c = col0 + bj * 128;
            const f32x4 g0 = *(const f32x4*)(gate + (size_t)batch * NMOD + c), g1 = *(const f32x4*)(gate + (size_t)batch * NMOD + c + 4);
#pragma unroll
            for (int ai = 0; ai < 2; ++ai)
#pragma unroll
                for (int m = 0; m < 4; ++m) {
                    const size_t off = (size_t)(row0 + ai * 128 + m * 16) * DM + c;
                    const f32x4 b0 = *(const f32x4*)(base + off), b1 = *(const f32x4*)(base + off + 4);
                    *(f32x4*)(out + off) = b0 * ALPHA + g0 * acc[ai][bj][m][0];
                    *(f32x4*)(out + off + 4) = b1 * ALPHA + g1 * acc[ai][bj][m][1];
                }
        }
    }
};
struct EpiSwiglu {
    static constexpr bool PERM = true, AFTER_DRAIN = false;
    bf16_t* U;
    __device__ __forceinline__ void operator()(const f32x4 (&acc)[2][2][4][2], const pg8::Unit& u, int wr, int wc, int fr, int fq) const {
        const int row0 = u.pm * 256 + wr * 64 + fr, col0 = u.pn * 128 + wc * 32 + 8 * fq;
#pragma unroll
        for (int ai = 0; ai < 2; ++ai)
#pragma unroll
            for (int m = 0; m < 4; ++m) {
                f32x4 r0, r1;
#pragma unroll
                for (int i = 0; i < 4; ++i) { r0[i] = silu_f(acc[ai][0][m][0][i]) * acc[ai][1][m][0][i]; r1[i] = silu_f(acc[ai][0][m][1][i]) * acc[ai][1][m][1][i]; }
                u32x4 w; w.x = pk2(r0[0], r0[1]); w.y = pk2(r0[2], r0[3]); w.z = pk2(r1[0], r1[1]); w.w = pk2(r1[2], r1[3]);
                *(u32x4*)(U + (size_t)(row0 + ai * 128 + m * 16) * DFF + col0) = w;
            }
    }
};

struct Args { const float* in[16]; float* out; unsigned char* ws; int ph_lo, ph_hi; };
struct Ctx { LAS unsigned char* lds; int tid, lane, wave; };
__device__ __forceinline__ Ctx mk_ctx(LAS unsigned char* lds) { Ctx X; int t = threadIdx.x; asm volatile("" : "+v"(t)); X.lds = lds; X.tid = t; X.lane = t & 63; X.wave = __builtin_amdgcn_readfirstlane(t >> 6); return X; }

template <int K> __device__ __forceinline__ f32x4 mma16(const LAS bf16_t* A, int sa, const LAS bf16_t* Bt, int sb, int fr, int fq, f32x4 acc) {
#pragma unroll
    for (int k0 = 0; k0 < K; k0 += 32) {
        const bf16x8 a = *(const LAS bf16x8*)(A + fr * sa + k0 + 8 * fq), b = *(const LAS bf16x8*)(Bt + fr * sb + k0 + 8 * fq);
        acc = __builtin_amdgcn_mfma_f32_16x16x32_bf16(a, b, acc, 0, 0, 0);
    }
    return acc;
}

__device__ __forceinline__ void ph_mod_partial(const Ctx& X, const float* c, const float* w_ada, float* modp) {
    LAS float* red = (LAS float*)X.lds;
    for (int item = blockIdx.x; item < 768; item += gridDim.x) {
        const int ks = item / 48, cb = item % 48, k0 = ks * 128 + X.wave * 16;
        const float* wp = w_ada + (size_t)k0 * NMOD + cb * 256 + X.lane * 4;
        f32x4 w[16];
#pragma unroll
        for (int i = 0; i < 16; ++i) w[i] = __builtin_nontemporal_load((const f32x4*)(wp + (size_t)i * NMOD));
        LAS float* cvs = (LAS float*)(X.lds + 32768) + X.wave * 64;
        { const int b = X.lane >> 4; const float v = c[b * DM + k0 + (X.lane & 15)]; cvs[X.lane] = v / (1.f + __expf(-v)); }
        f32x4 acc[4];
#pragma unroll
        for (int b = 0; b < 4; ++b) acc[b] = (f32x4){0.f, 0.f, 0.f, 0.f};
#pragma unroll
        for (int i = 0; i < 16; ++i) {
#pragma unroll
            for (int b = 0; b < 4; ++b) { const float s = cvs[b * 16 + i]; acc[b] += w[i] * s; }
        }
#pragma unroll
        for (int b = 0; b < 4; ++b) *(LAS f32x4*)(red + (X.wave * 4 + b) * 256 + X.lane * 4) = acc[b];
        __syncthreads();
#pragma unroll
        for (int k = 0; k < 2; ++k) { const int o = X.tid + NTHR * k, b = o >> 8, cc = o & 255; float s = 0.f;
#pragma unroll
            for (int w8 = 0; w8 < 8; ++w8) s += red[(w8 * 4 + b) * 256 + cc];
            modp[(size_t)(ks * 4 + b) * NMOD + cb * 256 + cc] = s; }
        __syncthreads();
    }
}

__device__ __forceinline__ float mod_value(const float* modp, const float* b_ada, int batch, int mc) {
    float s = b_ada[mc];
#pragma unroll
    for (int ks = 0; ks < 16; ++ks) s += modp[(size_t)(ks * 4 + batch) * NMOD + mc];
    return s;
}
__device__ __forceinline__ void ln_norm8(f32x4 (&v)[8]) {
    float s = 0.f;
#pragma unroll
    for (int j = 0; j < 8; ++j) s += (v[j][0] + v[j][1]) + (v[j][2] + v[j][3]);
    const float mean = wave_sum(s) * (1.f / DM); float q = 0.f;
#pragma unroll
    for (int j = 0; j < 8; ++j) { v[j] = v[j] - mean; q += (v[j][0] * v[j][0] + v[j][1] * v[j][1]) + (v[j][2] * v[j][2] + v[j][3] * v[j][3]); }
    const float rstd = 1.f / sqrtf(wave_sum(q) * (1.f / DM) + LN_EPS);
#pragma unroll
    for (int j = 0; j < 8; ++j) v[j] = v[j] * rstd;
}
__device__ __forceinline__ void ph_h1(const Ctx& X, const float* x, const float* modp, const float* b_ada, bf16_t* h) {
    LAS float* tab = (LAS float*)X.lds;
    for (int rb = blockIdx.x; rb < 256; rb += gridDim.x) {
        const int batch = rb >> 6;
        for (int i = X.tid; i < 4096; i += NTHR) { const float s = mod_value(modp, b_ada, batch, i); tab[i] = (i >= 2048) ? 1.f + s : s; }
        __syncthreads();
        for (int r = X.wave; r < 32; r += 8) {
            const size_t row = (size_t)rb * 32 + r; const float* xr = x + row * DM + 4 * X.lane;
            f32x4 v[8];
#pragma unroll
            for (int j = 0; j < 8; ++j) v[j] = *(const f32x4*)(xr + 256 * j);
            ln_norm8(v);
            bf16_t* hr = h + row * DM + 4 * X.lane;
#pragma unroll
            for (int j = 0; j < 8; ++j) {
                const int c = 4 * X.lane + 256 * j; const f32x4 sh = *(const LAS f32x4*)(tab + c), sc = *(const LAS f32x4*)(tab + 2048 + c);
                const f32x4 o = v[j] * sc + sh; u32x2 w; w.x = pk2(o[0], o[1]); w.y = pk2(o[2], o[3]); *(u32x2*)(hr + 256 * j) = w;
            }
        }
        __syncthreads();
    }
}
__device__ __forceinline__ int ffi_row(int c) { const int cc = c < DFF ? c : c - DFF; return ((cc >> 7) << 8) + (c < DFF ? 0 : 128) + (cc & 127); }
__device__ __forceinline__ void transpose_item(const float* W, int K, int N, bf16_t* WT, bool ffi, LAS float* scr, int item, int lane) {
    const int nblk = N / 32, kb = item / nblk, nb = item % nblk, k0 = 64 * kb, n0 = 32 * nb;
    const int r0 = ffi ? ffi_row(n0) : n0;
    f32x4 v[8];
    const float* wp = W + (size_t)(k0 + (lane >> 3)) * N + n0 + 4 * (lane & 7);
#pragma unroll
    for (int i = 0; i < 8; ++i) v[i] = __builtin_nontemporal_load((const f32x4*)(wp + (size_t)(8 * i) * N));
#pragma unroll
    for (int i = 0; i < 8; ++i) { LAS float* d = scr + (8 * i + (lane >> 3)) * 33 + 4 * (lane & 7); d[0] = v[i][0]; d[1] = v[i][1]; d[2] = v[i][2]; d[3] = v[i][3]; }
    asm volatile("s_waitcnt lgkmcnt(0)" ::: "memory");
    const int c = lane & 7;
#pragma unroll
    for (int j = 0; j < 4; ++j) { const int n = (lane >> 3) + 8 * j; const LAS float* s = scr + (8 * c) * 33 + n;
        u32x4 o; o.x = pk2(s[0 * 33], s[1 * 33]); o.y = pk2(s[2 * 33], s[3 * 33]); o.z = pk2(s[4 * 33], s[5 * 33]); o.w = pk2(s[6 * 33], s[7 * 33]);
        *(u32x4*)(WT + (size_t)(r0 + n) * K + k0 + 8 * c) = o; }
    asm volatile("s_waitcnt lgkmcnt(0)" ::: "memory");
}
__device__ __forceinline__ void ph_weights(const Ctx& X, int mask, int gw, int NGW, const float* w_in, const float* w_o, const float* w_fi, const float* w_fo, bf16_t* win_t, bf16_t* wo_t, bf16_t* wfi_t, bf16_t* wfo_t) {
    LAS float* scr = (LAS float*)(X.lds + X.wave * 16384);
    constexpr int I_IN = (DM / 64) * (NIN / 32), I_O = (DM / 64) * (DM / 32), I_FI = (DM / 64) * (NFF2 / 32), I_FO = (DFF / 64) * (DM / 32);
    const int n_in = (mask & 1) ? I_IN : 0, n_o = (mask & 2) ? I_O : 0, n_fi = (mask & 4) ? I_FI : 0, n_fo = (mask & 8) ? I_FO : 0;
    for (int it = gw; it < n_in + n_o + n_fi + n_fo; it += NGW) {
        int r = it;
        if (r < n_in) { transpose_item(w_in, DM, NIN, win_t, false, scr, r, X.lane); continue; } r -= n_in;
        if (r < n_o) { transpose_item(w_o, DM, DM, wo_t, false, scr, r, X.lane); continue; } r -= n_o;
        if (r < n_fi) { transpose_item(w_fi, DM, NFF2, wfi_t, true, scr, r, X.lane); continue; } r -= n_fi;
        transpose_item(w_fo, DFF, DM, wfo_t, false, scr, r, X.lane);
    }
}
__device__ __forceinline__ void ph_modf(const Ctx& X, const float* modp, const float* b_ada, float* modf) {
    for (int idx = blockIdx.x * NTHR + X.tid; idx < NB * NMOD; idx += gridDim.x * NTHR) { const int b = idx / NMOD, col = idx % NMOD; modf[idx] = mod_value(modp, b_ada, b, col); }
}

__device__ __forceinline__ void attn_unit(const Ctx& X, int b, int h, int c4, const bf16_t* qa, const bf16_t* ka, const bf16_t* va, const float* rel_bias, const float* again, bf16_t* mix) {
    constexpr int KS_OFF = 0, VT_OFF = 18432, TB_OFF = 36864, TILEB = 9216;
    const int lane = X.lane, wave = X.wave, tid = X.tid, r32 = lane & 31, hi = lane >> 5, wq = wave >> 1;
    const int qpos = (4 * c4 + wq) * 64 + (wave & 1) * 32 + r32;
    const size_t qrow = (size_t)b * SEQ + qpos;
    LAS float* tbr = (LAS float*)(X.lds + TB_OFF);
    for (int i = tid; i < 639; i += NTHR) { const int rel = 575 - i; tbr[i] = rel_bias[h * 513 + (rel < 256 ? rel : 256) + 256] * LOG2E; }
    bf16x8 qr[4];
#pragma unroll
    for (int d0 = 0; d0 < 4; ++d0) qr[d0] = *(const bf16x8*)(qa + qrow * AWID + h * 64 + d0 * 16 + hi * 8);
    f32x16 o0, o1;
#pragma unroll
    for (int r = 0; r < 16; ++r) { o0[r] = 0.f; o1[r] = 0.f; }
    float mrun = -1e30f, lrun = 0.f;
    const int tau_lo = (8 - 4 * c4) > 0 ? (8 - 4 * c4) : 0;
    const int krow = tid >> 3, kch = tid & 7, vrow = lane, vch = wave;
    const bf16_t* kbase = ka + ((size_t)b * SEQ + krow) * AWID + h * 64 + kch * 8;
    const bf16_t* vbase = va + ((size_t)b * SEQ + vrow) * AWID + h * 64 + vch * 8;
    u32x4 kreg, vreg, kreg2, vreg2;
#define ATT_GLOAD(tau, KR, VR) do { const long kt0_ = (long)(4 * c4 - 8 + (tau)) * 64; KR = *(const u32x4*)(kbase + kt0_ * AWID); VR = *(const u32x4*)(vbase + kt0_ * AWID); } while (0)
#define ATT_LSTORE(bufi) do { *(LAS u32x4*)(X.lds + KS_OFF + (bufi) * TILEB + krow * 144 + kch * 16) = kreg; \
        LAS bf16_t* vt_ = (LAS bf16_t*)(X.lds + VT_OFF + (bufi) * TILEB) + (vch * 8) * 72 + vrow; \
        vt_[0 * 72] = (bf16_t)(vreg.x & 0xffffu); vt_[1 * 72] = (bf16_t)(vreg.x >> 16); vt_[2 * 72] = (bf16_t)(vreg.y & 0xffffu); vt_[3 * 72] = (bf16_t)(vreg.y >> 16); \
        vt_[4 * 72] = (bf16_t)(vreg.z & 0xffffu); vt_[5 * 72] = (bf16_t)(vreg.z >> 16); vt_[6 * 72] = (bf16_t)(vreg.w & 0xffffu); vt_[7 * 72] = (bf16_t)(vreg.w >> 16); } while (0)
    ATT_GLOAD(tau_lo, kreg, vreg); ATT_LSTORE(0);
    ATT_GLOAD(tau_lo + 1, kreg, vreg);
    __syncthreads();
    const float cbias = tbr[0];
    int buf = 0;
    for (int tau = tau_lo; tau < 12; ++tau) {
        if (tau + 2 < 12) ATT_GLOAD(tau + 2, kreg2, vreg2);
        if (tau >= wq && tau <= wq + 8) {
            f32x16 p0, p1;
            const int kt0 = (4 * c4 - 8 + tau) * 64;
            if (tau - wq <= 3) {
#pragma unroll
                for (int r = 0; r < 16; ++r) { p0[r] = cbias; p1[r] = cbias; }
            } else {
                const LAS float* tb = tbr + (575 - qpos + kt0 + 4 * hi);
#pragma unroll
                for (int r = 0; r < 16; ++r) { const int off = (r & 3) + 8 * (r >> 2); p0[r] = tb[off]; p1[r] = tb[off + 32]; }
            }
            const LAS unsigned char* kb = X.lds + KS_OFF + buf * TILEB + r32 * 144 + hi * 16;
#pragma unroll
            for (int d0 = 0; d0 < 4; ++d0) {
                const bf16x8 k0 = *(const LAS bf16x8*)(kb + d0 * 32), k1 = *(const LAS bf16x8*)(kb + 32 * 144 + d0 * 32);
                p0 = __builtin_amdgcn_mfma_f32_32x32x16_bf16(k0, qr[d0], p0, 0, 0, 0);
                p1 = __builtin_amdgcn_mfma_f32_32x32x16_bf16(k1, qr[d0], p1, 0, 0, 0);
            }
            float mx = fmaxf(p0[0], p1[0]);
#pragma unroll
            for (int r = 1; r < 16; ++r) mx = fmaxf(mx, fmaxf(p0[r], p1[r]));
            mx = fmaxf(mx, __shfl_xor(mx, 32));
            if (__any(mx > mrun)) {
                const float mn = fmaxf(mrun, mx), al = __builtin_amdgcn_exp2f(mrun - mn); mrun = mn;
                lrun *= al;
#pragma unroll
                for (int r = 0; r < 16; ++r) { o0[r] *= al; o1[r] *= al; }
            }
            float ls = 0.f;
#pragma unroll
            for (int r = 0; r < 16; ++r) { p0[r] = __builtin_amdgcn_exp2f(p0[r] - mrun); p1[r] = __builtin_amdgcn_exp2f(p1[r] - mrun); ls += p0[r] + p1[r]; }
            lrun += ls;
            u32x4 pw[4];
            pw[0] = (u32x4){pk2(p0[0], p0[1]), pk2(p0[2], p0[3]), pk2(p0[4], p0[5]), pk2(p0[6], p0[7])};
            pw[1] = (u32x4){pk2(p0[8], p0[9]), pk2(p0[10], p0[11]), pk2(p0[12], p0[13]), pk2(p0[14], p0[15])};
            pw[2] = (u32x4){pk2(p1[0], p1[1]), pk2(p1[2], p1[3]), pk2(p1[4], p1[5]), pk2(p1[6], p1[7])};
            pw[3] = (u32x4){pk2(p1[8], p1[9]), pk2(p1[10], p1[11]), pk2(p1[12], p1[13]), pk2(p1[14], p1[15])};
            const LAS unsigned char* vb = X.lds + VT_OFF + buf * TILEB + r32 * 144 + hi * 8;
#pragma unroll
            for (int kb4 = 0; kb4 < 4; ++kb4) {
                const s16x4 a0l = *(const LAS s16x4*)(vb + kb4 * 32), a0h = *(const LAS s16x4*)(vb + kb4 * 32 + 16);
                const s16x4 a1l = *(const LAS s16x4*)(vb + 32 * 144 + kb4 * 32), a1h = *(const LAS s16x4*)(vb + 32 * 144 + kb4 * 32 + 16);
                const bf16x8 a0 = (bf16x8){a0l[0], a0l[1], a0l[2], a0l[3], a0h[0], a0h[1], a0h[2], a0h[3]};
                const bf16x8 a1 = (bf16x8){a1l[0], a1l[1], a1l[2], a1l[3], a1h[0], a1h[1], a1h[2], a1h[3]};
                const bf16x8 pf = __builtin_bit_cast(bf16x8, pw[kb4]);
                o0 = __builtin_amdgcn_mfma_f32_32x32x16_bf16(a0, pf, o0, 0, 0, 0);
                o1 = __builtin_amdgcn_mfma_f32_32x32x16_bf16(a1, pf, o1, 0, 0, 0);
            }
        }
        if (tau + 1 < 12) ATT_LSTORE(buf ^ 1);
        __syncthreads();
        buf ^= 1; kreg = kreg2; vreg = vreg2;
    }
#undef ATT_GLOAD
#undef ATT_LSTORE
    lrun += __shfl_xor(lrun, 32);
    const float inv = 1.f / lrun; float ss = 0.f;
#pragma unroll
    for (int r = 0; r < 16; ++r) { o0[r] *= inv; o1[r] *= inv; ss += o0[r] * o0[r] + o1[r] * o1[r]; }
    ss += __shfl_xor(ss, 32);
    const float rs = 1.f / sqrtf(ss * (1.f / 64.f) + LN_EPS);
    bf16_t* orow = mix + qrow * DM + h * 64;
#pragma unroll
    for (int rg = 0; rg < 4; ++rg) {
        const int d = 8 * rg + 4 * hi;
        const f32x4 g0 = *(const f32x4*)(again + h * 64 + d), g1 = *(const f32x4*)(again + h * 64 + 32 + d);
        u32x2 w0, w1;
        w0.x = pk2(o0[4 * rg + 0] * rs * g0[0], o0[4 * rg + 1] * rs * g0[1]); w0.y = pk2(o0[4 * rg + 2] * rs * g0[2], o0[4 * rg + 3] * rs * g0[3]);
        w1.x = pk2(o1[4 * rg + 0] * rs * g1[0], o1[4 * rg + 1] * rs * g1[1]); w1.y = pk2(o1[4 * rg + 2] * rs * g1[2], o1[4 * rg + 3] * rs * g1[3]);
        *(u32x2*)(orow + d) = w0; *(u32x2*)(orow + 32 + d) = w1;
    }
}

__device__ __forceinline__ void hgrnA_unit(const Ctx& X, int b, int h, int n, bf16_t* qb, const float* gl, const bf16_t* ib, float* ointra, bf16_t* U, float* adec) {
    constexpr int QS = 0, KS = 17408, K2T = 34816, IT = 53248, SC = 71680, SEG = 80896;
    LAS bf16_t* Qs = (LAS bf16_t*)(X.lds + QS); LAS bf16_t* Ks = (LAS bf16_t*)(X.lds + KS); LAS bf16_t* K2t = (LAS bf16_t*)(X.lds + K2T);
    LAS bf16_t* It = (LAS bf16_t*)(X.lds + IT); LAS bf16_t* Sc = (LAS bf16_t*)(X.lds + SC); LAS float* segsum = (LAS float*)(X.lds + SEG);
    const int tid = X.tid, lane = X.lane, wave = X.wave, fr = lane & 15, fq = lane >> 4;
    const size_t row0 = (size_t)b * SEQ + n * 64; const int cid = (b * 8 + h) * 32 + n;
    const int d4 = (tid & 31) * 4, ts = tid >> 5;
    f32x4 g[4], bb[4]; u32x2 qraw[4];
#pragma unroll
    for (int i = 0; i < 4; ++i) { const size_t ro = (row0 + 4 * ts + i) * AWID + h * 128 + d4; g[i] = *(const f32x4*)(gl + ro); qraw[i] = *(const u32x2*)(qb + ro); }
    u32x4 iv[2];
#pragma unroll
    for (int k = 0; k < 2; ++k) { const int p = tid + NTHR * k, s_ = p & 63, ch = p >> 6; iv[k] = *(const u32x4*)(ib + (row0 + s_) * AWID + h * 128 + ch * 8); }
    f32x4 run = (f32x4){0.f, 0.f, 0.f, 0.f};
#pragma unroll
    for (int i = 0; i < 4; ++i) { run += g[i]; bb[i] = run; }
    *(LAS f32x4*)(segsum + ts * 128 + d4) = run;
#pragma unroll
    for (int k = 0; k < 2; ++k) {
        const int p = tid + NTHR * k, s_ = p & 63, ch = p >> 6; const u32x4 v = iv[k];
        LAS bf16_t* it_ = It + (ch * 8) * 72 + s_;
        it_[0 * 72] = (bf16_t)(v.x & 0xffffu); it_[1 * 72] = (bf16_t)(v.x >> 16); it_[2 * 72] = (bf16_t)(v.y & 0xffffu); it_[3 * 72] = (bf16_t)(v.y >> 16);
        it_[4 * 72] = (bf16_t)(v.z & 0xffffu); it_[5 * 72] = (bf16_t)(v.z >> 16); it_[6 * 72] = (bf16_t)(v.w & 0xffffu); it_[7 * 72] = (bf16_t)(v.w >> 16);
    }
    __syncthreads();
    f32x4 off = (f32x4){0.f, 0.f, 0.f, 0.f}, tot = off;
#pragma unroll
    for (int s_ = 0; s_ < 16; ++s_) { const f32x4 v = *(const LAS f32x4*)(segsum + s_ * 128 + d4); tot += v; if (s_ < ts) off += v; }
    f32x4 etot;
#pragma unroll
    for (int j = 0; j < 4; ++j) etot[j] = fast_exp(tot[j]);
    f32x4 k2[4];
#pragma unroll
    for (int i = 0; i < 4; ++i) {
        const int t = 4 * ts + i; const f32x4 bv = bb[i] + off; f32x4 qt, kt;
        const float q0 = bflo(qraw[i].x), q1 = bfhi(qraw[i].x), q2 = bflo(qraw[i].y), q3 = bfhi(qraw[i].y);
        qt[0] = q0 * fast_exp(bv[0]); qt[1] = q1 * fast_exp(bv[1]); qt[2] = q2 * fast_exp(bv[2]); qt[3] = q3 * fast_exp(bv[3]);
#pragma unroll
        for (int j = 0; j < 4; ++j) { const float kk = 1.f - fast_exp(g[i][j]); kt[j] = kk * fast_exp(-bv[j]); k2[i][j] = kt[j] * etot[j]; }
        u32x2 wq_, wk_; wq_.x = pk2(qt[0], qt[1]); wq_.y = pk2(qt[2], qt[3]); wk_.x = pk2(kt[0], kt[1]); wk_.y = pk2(kt[2], kt[3]);
        *(LAS u32x2*)(Qs + t * 136 + d4) = wq_; *(u32x2*)(qb + (row0 + t) * AWID + h * 128 + d4) = wq_;
        *(LAS u32x2*)(Ks + t * 136 + d4) = wk_;
    }
#pragma unroll
    for (int j = 0; j < 4; ++j) { u32x2 w; w.x = pk2(k2[0][j], k2[1][j]); w.y = pk2(k2[2][j], k2[3][j]); *(LAS u32x2*)(K2t + (d4 + j) * 72 + 4 * ts) = w; }
    if (ts == 0) *(f32x4*)(adec + (size_t)cid * 128 + d4) = etot;
    __syncthreads();
    {
        const int sb = wave >> 1;
#pragma unroll
        for (int k = 0; k < 2; ++k) {
            const int tb = (wave & 1) * 2 + k; f32x4 acc = (f32x4){0.f, 0.f, 0.f, 0.f};
            if (tb >= sb) {
                acc = mma16<128>(Ks + sb * 16 * 136, 136, Qs + tb * 16 * 136, 136, fr, fq, acc);
                const int t_ = 16 * tb + fr, s_ = 16 * sb + 4 * fq;
#pragma unroll
                for (int j = 0; j < 4; ++j) if (s_ + j > t_) acc[j] = 0.f;
            }
            u32x2 w; w.x = pk2(acc[0], acc[1]); w.y = pk2(acc[2], acc[3]);
            *(LAS u32x2*)(Sc + (16 * tb + fr) * 72 + 16 * sb + 4 * fq) = w;
        }
    }
    __syncthreads();
    {
        const int tb = wave & 3;
#pragma unroll
        for (int k = 0; k < 4; ++k) {
            const int eb = (wave >> 2) * 4 + k; f32x4 acc = (f32x4){0.f, 0.f, 0.f, 0.f};
            acc = mma16<64>(It + eb * 16 * 72, 72, Sc + tb * 16 * 72, 72, fr, fq, acc);
            *(f32x4*)(ointra + (row0 + 16 * tb + fr) * AWID + h * 128 + 16 * eb + 4 * fq) = acc;
        }
    }
    {
        bf16_t* Uc = U + (size_t)cid * 16384;
#pragma unroll
        for (int eb = 0; eb < 8; ++eb) {
            f32x4 acc = (f32x4){0.f, 0.f, 0.f, 0.f};
            acc = mma16<64>(K2t + wave * 16 * 72, 72, It + eb * 16 * 72, 72, fr, fq, acc);
            u32x2 w; w.x = pk2(acc[0], acc[1]); w.y = pk2(acc[2], acc[3]);
            *(u32x2*)(Uc + (16 * eb + fr) * 128 + 16 * wave + 4 * fq) = w;
        }
    }
    __syncthreads();
}

__device__ __forceinline__ void ph_scan(const Ctx& X, const bf16_t* U, const float* adec, bf16_t* Sp) {
    for (int item = blockIdx.x; item < 256; item += gridDim.x) {
        const int bh = item >> 3, sl = item & 7, e = sl * 16 + (X.tid >> 5), d4 = (X.tid & 31) * 4;
        f32x4 S = (f32x4){0.f, 0.f, 0.f, 0.f};
#pragma unroll 4
        for (int n = 0; n < 32; ++n) {
            const int cid = bh * 32 + n; const size_t off = (size_t)cid * 16384 + e * 128 + d4;
            u32x2 w; w.x = pk2(S[0], S[1]); w.y = pk2(S[2], S[3]);
            *(u32x2*)(Sp + off) = w;
            const u32x2 uu = *(const u32x2*)(U + off); const f32x4 a = *(const f32x4*)(adec + (size_t)cid * 128 + d4);
            S[0] = a[0] * S[0] + bflo(uu.x); S[1] = a[1] * S[1] + bfhi(uu.x); S[2] = a[2] * S[2] + bflo(uu.y); S[3] = a[3] * S[3] + bfhi(uu.y);
        }
    }
}

__device__ __forceinline__ void hgrnC_unit(const Ctx& X, int b, int h, int n, const bf16_t* qb, const bf16_t* Sp, const float* ointra, const bf16_t* gb, const float* gng, bf16_t* mix) {
    constexpr int SS = 0, QS = 34816, SSQ = 52224;
    LAS bf16_t* Ss = (LAS bf16_t*)(X.lds + SS); LAS bf16_t* Qs = (LAS bf16_t*)(X.lds + QS); LAS float* ssq = (LAS float*)(X.lds + SSQ);
    const int tid = X.tid, lane = X.lane, wave = X.wave, fr = lane & 15, fq = lane >> 4;
    const size_t row0 = (size_t)b * SEQ + n * 64; const int cid = (b * 8 + h) * 32 + n;
#pragma unroll
    for (int k = 0; k < 4; ++k) { const int p = tid + NTHR * k, e = p >> 4, ch = p & 15; *(LAS u32x4*)(Ss + e * 136 + ch * 8) = *(const u32x4*)(Sp + (size_t)cid * 16384 + e * 128 + ch * 8); }
#pragma unroll
    for (int k = 0; k < 2; ++k) { const int p = tid + NTHR * k, t = p >> 4, ch = p & 15; *(LAS u32x4*)(Qs + t * 136 + ch * 8) = *(const u32x4*)(qb + (row0 + t) * AWID + h * 128 + ch * 8); }
    __syncthreads();
    const int tb = wave & 3, eh = wave >> 2; const size_t row = row0 + 16 * tb + fr;
    f32x4 acc[4]; float ss = 0.f;
#pragma unroll
    for (int k = 0; k < 4; ++k) {
        const int eb = eh * 4 + k;
        acc[k] = *(const f32x4*)(ointra + row * AWID + h * 128 + 16 * eb + 4 * fq);
        acc[k] = mma16<128>(Ss + eb * 16 * 136, 136, Qs + tb * 16 * 136, 136, fr, fq, acc[k]);
        ss += (acc[k][0] * acc[k][0] + acc[k][1] * acc[k][1]) + (acc[k][2] * acc[k][2] + acc[k][3] * acc[k][3]);
    }
    ss += __shfl_xor(ss, 16); ss += __shfl_xor(ss, 32);
    if (fq == 0) ssq[eh * 64 + 16 * tb + fr] = ss;
    __syncthreads();
    const float tot = ssq[16 * tb + fr] + ssq[64 + 16 * tb + fr], rs = 1.f / sqrtf(tot * (1.f / 128.f) + LN_EPS);
#pragma unroll
    for (int k = 0; k < 4; ++k) {
        const int e0 = 16 * (eh * 4 + k) + 4 * fq;
        const f32x4 gg = *(const f32x4*)(gng + e0); const u32x2 sg = *(const u32x2*)(gb + row * AWID + h * 128 + e0);
        u32x2 w;
        w.x = pk2(acc[k][0] * rs * gg[0] * bflo(sg.x), acc[k][1] * rs * gg[1] * bfhi(sg.x));
        w.y = pk2(acc[k][2] * rs * gg[2] * bflo(sg.y), acc[k][3] * rs * gg[3] * bfhi(sg.y));
        *(u32x2*)(mix + row * DM + 1024 + h * 128 + e0) = w;
    }
    __syncthreads();
}

__device__ __forceinline__ void ph_rows1(const Ctx& X, const float* y1, const float* ln_g, const float* ln_b, const float* modf, float* x1, bf16_t* h2) {
    LAS float* tab = (LAS float*)X.lds;
    for (int rb = blockIdx.x; rb < 256; rb += gridDim.x) {
        const int batch = rb >> 6;
        for (int i = X.tid; i < 2048; i += NTHR) { tab[i] = ln_g[i]; tab[2048 + i] = ln_b[i]; tab[4096 + i] = 1.f + modf[(size_t)batch * NMOD + 4 * DM + i]; tab[6144 + i] = modf[(size_t)batch * NMOD + 3 * DM + i]; }
        __syncthreads();
        for (int r = X.wave; r < 32; r += 8) {
            const size_t row = (size_t)rb * 32 + r; const float* yr = y1 + row * DM + 4 * X.lane;
            f32x4 v[8];
#pragma unroll
            for (int j = 0; j < 8; ++j) v[j] = *(const f32x4*)(yr + 256 * j);
            ln_norm8(v);
            float* xr = x1 + row * DM + 4 * X.lane;
#pragma unroll
            for (int j = 0; j < 8; ++j) { const int c = 4 * X.lane + 256 * j; v[j] = v[j] * *(const LAS f32x4*)(tab + c) + *(const LAS f32x4*)(tab + 2048 + c); *(f32x4*)(xr + 256 * j) = v[j]; }
            ln_norm8(v);
            bf16_t* hr = h2 + row * DM + 4 * X.lane;
#pragma unroll
            for (int j = 0; j < 8; ++j) { const int c = 4 * X.lane + 256 * j; const f32x4 o = v[j] * *(const LAS f32x4*)(tab + 4096 + c) + *(const LAS f32x4*)(tab + 6144 + c);
                u32x2 w; w.x = pk2(o[0], o[1]); w.y = pk2(o[2], o[3]); *(u32x2*)(hr + 256 * j) = w; }
        }
        __syncthreads();
    }
}
__device__ __forceinline__ void ph_rows2(const Ctx& X, float* y2, const float* ln_g, const float* ln_b) {
    LAS float* tab = (LAS float*)X.lds;
    for (int i = X.tid; i < 2048; i += NTHR) { tab[i] = ln_g[i]; tab[2048 + i] = ln_b[i]; }
    __syncthreads();
    for (int row = blockIdx.x * 8 + X.wave; row < MROWS; row += gridDim.x * 8) {
        float* yr = y2 + (size_t)row * DM + 4 * X.lane;
        f32x4 v[8];
#pragma unroll
        for (int j = 0; j < 8; ++j) v[j] = *(const f32x4*)(yr + 256 * j);
        ln_norm8(v);
#pragma unroll
        for (int j = 0; j < 8; ++j) { const int c = 4 * X.lane + 256 * j; *(f32x4*)(yr + 256 * j) = v[j] * *(const LAS f32x4*)(tab + c) + *(const LAS f32x4*)(tab + 2048 + c); }
    }
    __syncthreads();
}

#define XB_TMO      128
#define XB_XCNT(j)  (256  + 64 * (j))
#define XB_XSUB(j)  (1280 + 64 * (j))
#define XB_XGEN(j)  (2304 + 64 * (j))
#define XB_TOP      3328
#define XB_TOPGEN   3392
#define XCD_BAR_WORDS 3456
#define XB_SPIN_CAP (1u << 18)

__device__ __forceinline__ unsigned xb_ld(unsigned* p)              { return __hip_atomic_load(p, __ATOMIC_RELAXED, __HIP_MEMORY_SCOPE_AGENT); }
__device__ __forceinline__ unsigned xb_add(unsigned* p, unsigned v) { return __hip_atomic_fetch_add(p, v, __ATOMIC_RELAXED, __HIP_MEMORY_SCOPE_AGENT); }
__device__ __forceinline__ unsigned xb_xcc_id() { return (unsigned)__builtin_amdgcn_s_getreg((3 << 11) | 20) & 0xFu; }
#define XB_SPIN(cond, bar) do { unsigned _sp = 0; while (cond) { __builtin_amdgcn_s_sleep(1); \
    if ((++_sp & 255u) == 0u) { if (xb_ld(&(bar)[XB_TMO])) break; if (_sp > XB_SPIN_CAP) { atomicAdd(&(bar)[XB_TMO], 1u); break; } } } } while (0)

struct XcdBarrier {
    unsigned* bar; unsigned x;
    volatile LAS unsigned* st;
};

__device__ __forceinline__ XcdBarrier xcd_barrier_post(unsigned* bar, volatile LAS unsigned* st) {
    XcdBarrier b; b.bar = bar; b.x = xb_xcc_id(); b.st = st;
    if (threadIdx.x == 0) (void)xb_add(&bar[XB_XCNT(b.x)], 1u);
    return b;
}
__device__ __forceinline__ void xcd_barrier_complete(unsigned* bar, unsigned x, unsigned& nloc, unsigned& nx) {
    const unsigned G = gridDim.x * gridDim.y * gridDim.z;
    unsigned sum, cnt, mine, sp = 0u;
    for (;;) {
        sum = 0u; cnt = 0u; mine = 0u;
#pragma unroll
        for (unsigned j = 0; j < 16; ++j) { const unsigned c = xb_ld(&bar[XB_XCNT(j)]); sum += c; cnt += (c > 0u) ? 1u : 0u; mine = (j == x) ? c : mine; }
        if (sum == G) break;
        __builtin_amdgcn_s_sleep(1);
        if ((++sp & 255u) == 0u) { if (xb_ld(&bar[XB_TMO])) break; if (sp > XB_SPIN_CAP) { atomicAdd(&bar[XB_TMO], 1u); break; } }
    }
    nloc = mine > 0u ? mine : 1u; nx = cnt > 0u ? cnt : 1u;
}

__device__ __forceinline__ void xcd_barrier(const XcdBarrier& b) {
    asm volatile("s_waitcnt vmcnt(0)" ::: "memory");
    __syncthreads();
    if (threadIdx.x == 0) {
        unsigned* bar = b.bar;
        __builtin_amdgcn_s_waitcnt(0);
        unsigned nloc = b.st[0], nx = b.st[1];
        if (nloc == 0u) { xcd_barrier_complete(bar, b.x, nloc, nx); b.st[0] = nloc; b.st[1] = nx; }
        const unsigned old = xb_add(&bar[XB_XSUB(b.x)], 1u);
        const unsigned gen = old / nloc;
        if (old + 1u == (gen + 1u) * nloc) {
            __builtin_amdgcn_fence(__ATOMIC_RELEASE, "agent");
            asm volatile("s_waitcnt vmcnt(0)" ::: "memory");
            const unsigned og = xb_add(&bar[XB_TOP], 1u);
            const unsigned tg = og / nx;
            if (og + 1u == (tg + 1u) * nx) xb_add(&bar[XB_TOPGEN], 1u);
            else XB_SPIN(xb_ld(&bar[XB_TOPGEN]) == tg, bar);
            __builtin_amdgcn_fence(__ATOMIC_ACQUIRE, "agent");
            xb_add(&bar[XB_XGEN(b.x)], 1u);
            asm volatile("s_waitcnt vmcnt(0)" ::: "memory");
        } else {
            XB_SPIN(xb_ld(&bar[XB_XGEN(b.x)]) == gen, bar);
            __builtin_amdgcn_fence(__ATOMIC_ACQUIRE, "agent");
            asm volatile("s_waitcnt vmcnt(0)" ::: "memory");
        }
    }
    __syncthreads();
}

constexpr int N_PHASES = 11;
constexpr int BAR_LDS_OFF = 131072 + 64;
constexpr size_t CTL_ZERO_BYTES = 16384;
#ifndef MK_PER_PHASE
#define MK_PER_PHASE 0
#endif
#ifndef PROBE_PHASE
#define PROBE_PHASE -1
#endif
#ifndef PROBE_MASK
#define PROBE_MASK 0
#endif
#define PROBE_T0(k) do { if ((PROBE_MASK >> (k)) & 1) pt0_ = __builtin_amdgcn_s_memrealtime(); } while (0)
#define PROBE_DLY(k) do { if ((PROBE_MASK >> (k)) & 1) { const unsigned long long t1_ = __builtin_amdgcn_s_memrealtime(), dt_ = t1_ - pt0_; while (__builtin_amdgcn_s_memrealtime() - t1_ < dt_) __builtin_amdgcn_s_sleep(8); } } while (0)
#define REP(k) for (int rep_ = 0; rep_ < ((PROBE_PHASE == (k)) ? 2 : 1); ++rep_)
__device__ __forceinline__ bool ph_in(int lo, int hi, int k) { asm volatile("" : "+s"(lo), "+s"(hi)); return lo <= k && k < hi; }
__global__ void __launch_bounds__(NTHR, 2) mk_fwd(Args a) {
    extern __shared__ __attribute__((aligned(16))) unsigned char lds_raw[];
    LAS unsigned char* const ldsb = (LAS unsigned char*)lds_raw;
#define X mk_ctx(ldsb)
    unsigned char* ws = a.ws;
    const float *x = a.in[0], *c = a.in[1], *w_ada = a.in[2], *b_ada = a.in[3], *w_in = a.in[4], *rel_bias = a.in[5], *attn_g = a.in[6], *lb_logits = a.in[7], *gnorm_g = a.in[8],
                *w_o = a.in[9], *ln1_g = a.in[10], *ln1_b = a.in[11], *w_fi = a.in[12], *w_fo = a.in[13], *ln2_g = a.in[14], *ln2_b = a.in[15];
    float* modp = (float*)(ws + WS_MODP); float* modf = (float*)(ws + WS_MODF);
    bf16_t *win_t = (bf16_t*)(ws + WS_WIN), *wo_t = (bf16_t*)(ws + WS_WO), *wfi_t = (bf16_t*)(ws + WS_WFI), *wfo_t = (bf16_t*)(ws + WS_WFO);
    float* adec = (float*)(ws + WS_ADEC);
    bf16_t* hbuf = (bf16_t*)(ws + WS_H); float* ointra = (float*)(ws + WS_H);
    bf16_t *qa = (bf16_t*)(ws + WS_QA), *ka = (bf16_t*)(ws + WS_KA), *va = (bf16_t*)(ws + WS_VA), *qb = (bf16_t*)(ws + WS_QB), *ib = (bf16_t*)(ws + WS_IB), *gb = (bf16_t*)(ws + WS_GB);
    float* gl = (float*)(ws + WS_GL);
    bf16_t *mix = (bf16_t*)(ws + WS_MIX), *U = (bf16_t*)(ws + WS_U), *Sp = (bf16_t*)(ws + WS_SP), *uff = (bf16_t*)(ws + WS_UFF);
    float *y1 = (float*)(ws + WS_Y1), *x1 = (float*)(ws + WS_X1);
#define tail_cvt (gridDim.x == 256)
#if MK_PER_PHASE
#define IN(k) ph_in(a.ph_lo, a.ph_hi, (k))
#define SEAM(k) do { } while (0)
#else
#define IN(k) true
#define SEAM(k) do { xcd_barrier(bar); PROBE_DLY(k); PROBE_T0((k) + 1); } while (0)
    unsigned long long pt0_ = 0; PROBE_T0(0);
    if (X.tid < 2) ((volatile LAS unsigned*)(X.lds + BAR_LDS_OFF))[X.tid] = 0u;
    __syncthreads();
    XcdBarrier bar = xcd_barrier_post((unsigned*)ws, (volatile LAS unsigned*)(X.lds + BAR_LDS_OFF));
    if (a.ph_lo == 0x7fffffff) cg::this_grid().sync();
#endif

#if PROBE_PHASE == 99
    for (int pass_ = 0; pass_ < 2; ++pass_) {
#endif
    if (IN(0)) { ph_mod_partial(X, c, w_ada, modp); }
#if PROBE_PHASE == 0
    ph_mod_partial(X, c, w_ada, modp);
#endif
    SEAM(0);
    if (IN(1)) { ph_h1(X, x, modp, b_ada, hbuf); ph_modf(X, modp, b_ada, modf); ph_weights(X, tail_cvt ? 1 : 15, (int)blockIdx.x * 8 + X.wave, (int)gridDim.x * 8, w_in, w_o, w_fi, w_fo, win_t, wo_t, wfi_t, wfo_t); }
#if PROBE_PHASE == 1
    __syncthreads(); ph_h1(X, x, modp, b_ada, hbuf);
#endif
#if PROBE_PHASE == 11
    __syncthreads(); ph_weights(X, tail_cvt ? 1 : 15, (int)blockIdx.x * 8 + X.wave, (int)gridDim.x * 8, w_in, w_o, w_fi, w_fo, win_t, wo_t, wfi_t, wfo_t);
#endif
    SEAM(1);
    if (IN(2)) {
        pg8::Gemm g{hbuf, win_t, MROWS, NIN, DM}; pg8::StaticOrder S; S.init(MROWS, NIN, (int)gridDim.x, (int)blockIdx.x);
        EpiInProj E{qa, ka, va, qb, ib, gb, gl, lb_logits};
        pg8::gemm_phase<EpiInProj, pg8::StaticOrder, true, true>(X.lds, g, S, E);
        if (tail_cvt && blockIdx.x >= 128) ph_weights(X, 2 | 4, ((int)blockIdx.x - 128) * 8 + X.wave, 128 * 8, w_in, w_o, w_fi, w_fo, win_t, wo_t, wfi_t, wfo_t);
    }
#if PROBE_PHASE == 2
    {
        pg8::Gemm g{hbuf, win_t, MROWS, NIN, DM}; pg8::StaticOrder S; S.init(MROWS, NIN, (int)gridDim.x, (int)blockIdx.x);
        EpiInProj E{qa, ka, va, qb, ib, gb, gl, lb_logits};
        pg8::gemm_phase<EpiInProj, pg8::StaticOrder, true, true>(X.lds, g, S, E);
    }
#endif
    SEAM(2);
    if (IN(3)) {
        __syncthreads();
        REP(30) for (int u = blockIdx.x; u < 512; u += gridDim.x) { const int c4 = u & 7, bh = u >> 3; attn_unit(X, bh >> 4, bh & 15, c4, qa, ka, va, rel_bias, attn_g, mix); }
        for (int u = blockIdx.x; u < 1024; u += gridDim.x) { const int n = u & 31, bh = u >> 5; hgrnA_unit(X, bh >> 3, bh & 7, n, qb, gl, ib, ointra, U, adec); }
    } SEAM(3);
    if (IN(4)) { ph_scan(X, U, adec, Sp); }
#if PROBE_PHASE == 4
    ph_scan(X, U, adec, Sp);
#endif
    SEAM(4);
    if (IN(5)) REP(5) {
        for (int u = blockIdx.x; u < 1024; u += gridDim.x) { const int n = u & 31, bh = u >> 5; hgrnC_unit(X, bh >> 3, bh & 7, n, qb, Sp, ointra, gb, gnorm_g, mix); }
    } SEAM(5);
    if (IN(6)) {
        pg8::Gemm g{mix, wo_t, MROWS, DM, DM}; pg8::StaticOrder S; S.init(MROWS, DM, (int)gridDim.x, (int)blockIdx.x);
        EpiResid E{x, modf + 2 * DM, y1};
        pg8::gemm_phase<EpiResid, pg8::StaticOrder, true, true>(X.lds, g, S, E);
    }
#if PROBE_PHASE == 6
    {
        pg8::Gemm g{mix, wo_t, MROWS, DM, DM}; pg8::StaticOrder S; S.init(MROWS, DM, (int)gridDim.x, (int)blockIdx.x);
        EpiResid E{x, modf + 2 * DM, y1};
        pg8::gemm_phase<EpiResid, pg8::StaticOrder, true, true>(X.lds, g, S, E);
    }
#endif
    SEAM(6);
    if (IN(7)) { __syncthreads(); ph_rows1(X, y1, ln1_g, ln1_b, modf, x1, hbuf); }
#if PROBE_PHASE == 7
    ph_rows1(X, y1, ln1_g, ln1_b, modf, x1, hbuf);
#endif
    SEAM(7);
    if (IN(8)) {
        pg8::Gemm g{hbuf, wfi_t, MROWS, NFF2, DM}; pg8::StaticOrder S; S.init(MROWS, NFF2, (int)gridDim.x, (int)blockIdx.x);
        EpiSwiglu E{uff};
        pg8::gemm_phase<EpiSwiglu, pg8::StaticOrder, true, true>(X.lds, g, S, E);
        if (tail_cvt && blockIdx.x >= 128) ph_weights(X, 8, ((int)blockIdx.x - 128) * 8 + X.wave, 128 * 8, w_in, w_o, w_fi, w_fo, win_t, wo_t, wfi_t, wfo_t);
    }
#if PROBE_PHASE == 8
    {
        pg8::Gemm g{hbuf, wfi_t, MROWS, NFF2, DM}; pg8::StaticOrder S; S.init(MROWS, NFF2, (int)gridDim.x, (int)blockIdx.x);
        EpiSwiglu E{uff};
        pg8::gemm_phase<EpiSwiglu, pg8::StaticOrder, true, true>(X.lds, g, S, E);
    }
#endif
    SEAM(8);
    if (IN(9)) {
        pg8::Gemm g{uff, wfo_t, MROWS, DM, DFF}; pg8::StaticOrder S; S.init(MROWS, DM, (int)gridDim.x, (int)blockIdx.x);
        EpiResid E{x1, modf + 5 * DM, a.out};
        pg8::gemm_phase<EpiResid, pg8::StaticOrder, true, true>(X.lds, g, S, E);
    }
#if PROBE_PHASE == 9
    {
        pg8::Gemm g{uff, wfo_t, MROWS, DM, DFF}; pg8::StaticOrder S; S.init(MROWS, DM, (int)gridDim.x, (int)blockIdx.x);
        EpiResid E{x1, modf + 5 * DM, a.out};
        pg8::gemm_phase<EpiResid, pg8::StaticOrder, true, true>(X.lds, g, S, E);
    }
#endif
    SEAM(9);
    if (IN(10)) { __syncthreads(); ph_rows2(X, a.out, ln2_g, ln2_b); PROBE_DLY(10); }
#if PROBE_PHASE == 99
    if (pass_ == 0) xcd_barrier(bar);
    }
#endif
#undef IN
#undef SEAM
#undef X
#undef tail_cvt
}

#ifndef MK_PER_PHASE
#define MK_PER_PHASE 0
#endif
extern "C" void kernel_launch(void* const* d_in, const int* in_sizes, int n_in, void* d_out, int out_size, void* d_ws, size_t ws_size, hipStream_t stream) {
    static int grid = 0;
    if (grid == 0) {
        if (n_in != 16 || in_sizes[0] != MROWS * DM || out_size != MROWS * DM || ws_size < WS_END) {
            fprintf(stderr, "kernel_launch: unexpected shapes (n_in %d, in0 %d, out %d, ws %zu; need ws >= %zu); nothing launched\n", n_in, n_in > 0 ? in_sizes[0] : -1, out_size, ws_size, (size_t)WS_END); grid = -1; return; }
        int dev = 0, cus = 0, per_cu = 0;
        hipGetDevice(&dev); hipDeviceGetAttribute(&cus, hipDeviceAttributeMultiprocessorCount, dev);
        if (hipFuncSetAttribute((const void*)mk_fwd, hipFuncAttributeMaxDynamicSharedMemorySize, LDS_BYTES) != hipSuccess) { fprintf(stderr, "kernel_launch: hipFuncSetAttribute failed\n"); grid = -1; return; }
        if (hipOccupancyMaxActiveBlocksPerMultiprocessor(&per_cu, (const void*)mk_fwd, NTHR, LDS_BYTES) != hipSuccess || per_cu < 1) { fprintf(stderr, "kernel_launch: occupancy query says %d blocks per CU\n", per_cu); (void)hipGetLastError(); grid = -1; return; }
        grid = cus;
    }
    if (grid < 0) return;
    Args a{};
    for (int i = 0; i < 16; ++i) a.in[i] = (const float*)d_in[i];
    a.out = (float*)d_out; a.ws = (unsigned char*)d_ws;
#if MK_PER_PHASE
    for (int p = 0; p < N_PHASES; ++p) {
        a.ph_lo = p; a.ph_hi = p + 1; void* args[] = {&a};
        hipError_t e = hipLaunchCooperativeKernel((const void*)mk_fwd, dim3(grid), dim3(NTHR), args, LDS_BYTES, stream);
        if (e != hipSuccess) { fprintf(stderr, "kernel_launch: launch %d failed: %s\n", p, hipGetErrorString(e)); break; }
    }
#else
    if (hipMemsetAsync(d_ws, 0, CTL_ZERO_BYTES, stream) != hipSuccess) { fprintf(stderr, "kernel_launch: memset of the barrier words failed\n"); return; }
    a.ph_lo = 0; a.ph_hi = N_PHASES; void* args[] = {&a};
    hipError_t e = hipLaunchCooperativeKernel((const void*)mk_fwd, dim3(grid), dim3(NTHR), args, LDS_BYTES, stream);
    if (e != hipSuccess) fprintf(stderr, "kernel_launch: cooperative launch failed: %s (grid %d)\n", hipGetErrorString(e), grid);
#if PROBE_PHASE == 98
    (void)hipMemsetAsync(d_ws, 0, CTL_ZERO_BYTES, stream);
    (void)hipLaunchCooperativeKernel((const void*)mk_fwd, dim3(grid), dim3(NTHR), args, LDS_BYTES, stream);
#endif
#endif
}
```
